# Optimizing an MI355X kernel written in HIP

```python
import jax, jax.numpy as jnp
from jax import lax
import numpy as np

D_MODEL = 1024
BATCH = 16
SEQ = 4096
DEPTH = 1
DEC_BATCH = 8
DEC_SEQ = 4096
PAST_LEN = 128

DIL_GROUPS = ((128, 1), (512, 4), (2048, 16))
N_GROUPS = 3
A_HEADS = 8
A_HEAD_DIM = 64
A_WIDTH = A_HEADS * A_HEAD_DIM
A_QKV = N_GROUPS * A_WIDTH
ROT_DIM = A_HEAD_DIM // 4
ROPE_THETA = 500000.0

M_HEADS = 8
Q_LORA = 256
KV_LORA = 128
NOPE = 64
ROPE_D = 32
V_DIM = 64
B_WIDTH = M_HEADS * V_DIM
MLA_THETA = 10000.0
Q_BLOCK = 128

EPS = 1e-6
NEG = -1e30
SPLIT_SIZES = (A_QKV, A_QKV, A_QKV, A_WIDTH, Q_LORA, KV_LORA, ROPE_D, B_WIDTH, D_MODEL, D_MODEL)
N_IN = 3 * A_QKV + A_WIDTH + Q_LORA + KV_LORA + ROPE_D + B_WIDTH + 2 * D_MODEL

kernel_name = "hybrid_dilated_mla_gated_encoder"


def rmsnorm(x, g):
    xf = x.astype(jnp.float32)
    y = xf * lax.rsqrt(jnp.mean(xf * xf, axis=-1, keepdims=True) + EPS) * g.astype(jnp.float32)
    return y.astype(x.dtype)


def rope(t, pos, theta, rot_dim):
    half = rot_dim // 2
    inv = jnp.float32(theta) ** (-jnp.arange(half, dtype=jnp.float32) * (2.0 / rot_dim))
    ang = pos[:, None] * inv[None, :]
    c = jnp.cos(ang)[:, None, :]
    s = jnp.sin(ang)[:, None, :]
    tf = t.astype(jnp.float32)
    x1 = tf[..., :half]
    x2 = tf[..., half:rot_dim]
    out = jnp.concatenate([x1 * c - x2 * s, x2 * c + x1 * s, tf[..., rot_dim:]], axis=-1)
    return out.astype(t.dtype)


def dilated_band_attention(q, k, v, dil, band):
    B, S, H, Dh = q.shape
    unit = dil * band
    Sp = -(-S // unit) * unit
    pad = Sp - S
    M = Sp // dil
    nb = M // band

    def to_blocks(t):
        t = jnp.pad(t, ((0, 0), (0, pad), (0, 0), (0, 0)))
        t = t.reshape(B, M, dil, H, Dh).transpose(0, 2, 1, 3, 4)
        return t.reshape(B, dil, nb, band, H, Dh)

    def neighbours(t):
        tp = jnp.pad(t, ((0, 0), (0, 0), (1, 1), (0, 0), (0, 0), (0, 0)))
        return jnp.concatenate([tp[:, :, :-2], tp[:, :, 1:-1], tp[:, :, 2:]], axis=3)

    qb = to_blocks(q)
    kn = neighbours(to_blocks(k))
    vn = neighbours(to_blocks(v))

    qi = jnp.arange(band)[:, None]
    kj = jnp.arange(3 * band)[None, :] - band
    band_ok = jnp.abs(kj - qi) <= band
    m_key = (jnp.arange(nb)[:, None] - 1) * band + jnp.arange(3 * band)[None, :]
    pos_key = m_key[None] * dil + jnp.arange(dil)[:, None, None]
    key_ok = (m_key[None] >= 0) & (pos_key < S)
    mask = band_ok[None, None] & key_ok[:, :, None, :]

    scale = Dh ** -0.5
    s = jnp.einsum('brnqhd,brnkhd->brnhqk', qb, kn).astype(jnp.float32) * scale
    s = jnp.where(mask[None, :, :, None], s, NEG)
    lse = jax.nn.logsumexp(s, axis=-1)
    p = jnp.exp(s - lse[..., None])
    o = jnp.einsum('brnhqk,brnkhd->brnqhd', p.astype(v.dtype), vn)
    o = o.reshape(B, dil, M, H, Dh).transpose(0, 2, 1, 3, 4).reshape(B, Sp, H, Dh)[:, :S]
    lse = lse.transpose(0, 1, 2, 4, 3).reshape(B, dil, M, H).transpose(0, 2, 1, 3).reshape(B, Sp, H)[:, :S]
    return o, lse


def mla_attention(q_lat, kv_lat, k_rope, g_q, w_q_up, g_kv, w_kv_up, pos):
    B, S, _ = q_lat.shape
    q = (rmsnorm(q_lat, g_q) @ w_q_up).reshape(B, S, M_HEADS, NOPE + ROPE_D)
    q_nope = q[..., :NOPE]
    q_pe = rope(q[..., NOPE:], pos, MLA_THETA, ROPE_D)
    kv = (rmsnorm(kv_lat, g_kv) @ w_kv_up).reshape(B, S, M_HEADS, NOPE + V_DIM)
    k_nope = kv[..., :NOPE]
    v = kv[..., NOPE:]
    k_pe = rope(k_rope[:, :, None, :], pos, MLA_THETA, ROPE_D)[:, :, 0, :]
    scale = (NOPE + ROPE_D) ** -0.5
    nq = S // Q_BLOCK
    qn_b = q_nope.reshape(B, nq, Q_BLOCK, M_HEADS, NOPE).transpose(1, 0, 2, 3, 4)
    qp_b = q_pe.reshape(B, nq, Q_BLOCK, M_HEADS, ROPE_D).transpose(1, 0, 2, 3, 4)

    def block(args):
        qn, qp = args
        s = (jnp.einsum('bqhd,bkhd->bhqk', qn, k_nope)
             + jnp.einsum('bqhd,bkd->bhqk', qp, k_pe)).astype(jnp.float32) * scale
        p = jax.nn.softmax(s, axis=-1)
        return jnp.einsum('bhqk,bkhd->bqhd', p.astype(v.dtype), v)

    o = lax.map(block, (qn_b, qp_b))
    return o.transpose(1, 0, 2, 3, 4).reshape(B, S, B_WIDTH)


def hybrid_layer(x, g_pre, w_in, g_q, w_q_up, g_kv, w_kv_up, w_out_a, w_out_b, w_out):
    B, S, _ = x.shape
    pos = jnp.arange(S, dtype=jnp.float32)
    h = rmsnorm(x, g_pre)
    z = h @ w_in
    idx = [int(i) for i in np.cumsum(SPLIT_SIZES)[:-1]]
    qa, ka, va, gate_a, q_lat, kv_lat, k_rope, gate_b, mg_a, mg_b = jnp.split(z, idx, axis=-1)

    n_h = N_GROUPS * A_HEADS
    qa = rope(qa.reshape(B, S, n_h, A_HEAD_DIM), pos, ROPE_THETA, ROT_DIM)
    ka = rope(ka.reshape(B, S, n_h, A_HEAD_DIM), pos, ROPE_THETA, ROT_DIM)
    va = va.reshape(B, S, n_h, A_HEAD_DIM)
    outs, lses = [], []
    for g, (win, dil) in enumerate(DIL_GROUPS):
        sl = slice(g * A_HEADS, (g + 1) * A_HEADS)
        o, l = dilated_band_attention(qa[:, :, sl], ka[:, :, sl], va[:, :, sl], dil, win // (2 * dil))
        outs.append(o)
        lses.append(l)
    wts = jax.nn.softmax(jnp.stack(lses, axis=0), axis=0)
    out_a = jnp.sum(wts[..., None] * jnp.stack(outs, axis=0).astype(jnp.float32), axis=0)
    out_a = out_a.astype(x.dtype).reshape(B, S, A_WIDTH)
    br_a = (out_a * jax.nn.silu(gate_a)) @ w_out_a

    out_b = mla_attention(q_lat, kv_lat, k_rope, g_q, w_q_up, g_kv, w_kv_up, pos)
    br_b = (out_b * jax.nn.silu(gate_b)) @ w_out_b

    merged = jax.nn.sigmoid(mg_a) * br_a + jax.nn.sigmoid(mg_b) * br_b
    return x + merged @ w_out


def trunk(x, g_pre, w_in, g_q, w_q_up, g_kv, w_kv_up, w_out_a, w_out_b, w_out, g_final):
    for l in range(DEPTH):
        x = hybrid_layer(x, g_pre[l], w_in[l], g_q[l], w_q_up[l], g_kv[l], w_kv_up[l],
                         w_out_a[l], w_out_b[l], w_out[l])
    return rmsnorm(x, g_final)


def setup_inputs(seed: int = 0) -> dict:
    key = jax.random.key(seed)
    ks = jax.random.split(key, 13)
    f32 = jnp.float32

    def w(k, shape, fan_in):
        return jax.random.normal(k, shape, f32) * (fan_in ** -0.5)

    def gain(k, shape):
        return jnp.ones(shape, f32) + 0.01 * jax.random.normal(k, shape, f32)

    return {
        "x_prompt": jax.random.normal(ks[0], (BATCH, SEQ, D_MODEL), f32),
        "x_sample": jax.random.normal(ks[1], (DEC_BATCH, DEC_SEQ, D_MODEL), f32),
        "g_pre": gain(ks[2], (DEPTH, D_MODEL)),
        "w_in": w(ks[3], (DEPTH, D_MODEL, N_IN), D_MODEL),
        "g_q": gain(ks[4], (DEPTH, Q_LORA)),
        "w_q_up": w(ks[5], (DEPTH, Q_LORA, M_HEADS * (NOPE + ROPE_D)), Q_LORA),
        "g_kv": gain(ks[6], (DEPTH, KV_LORA)),
        "w_kv_up": w(ks[7], (DEPTH, KV_LORA, M_HEADS * (NOPE + V_DIM)), KV_LORA),
        "w_out_a": w(ks[8], (DEPTH, A_WIDTH, D_MODEL), A_WIDTH),
        "w_out_b": w(ks[9], (DEPTH, B_WIDTH, D_MODEL), B_WIDTH),
        "w_out": w(ks[10], (DEPTH, D_MODEL, D_MODEL), D_MODEL),
        "g_final": gain(ks[11], (D_MODEL,)),
    }


def reference(x_prompt, x_sample, g_pre, w_in, g_q, w_q_up, g_kv, w_kv_up, w_out_a, w_out_b, w_out, g_final):
    y_prompt = trunk(x_prompt, g_pre, w_in, g_q, w_q_up, g_kv, w_kv_up, w_out_a, w_out_b, w_out, g_final)
    y_sample = trunk(x_sample, g_pre, w_in, g_q, w_q_up, g_kv, w_kv_up, w_out_a, w_out_b, w_out, g_final)
    return (y_prompt, y_sample)
```

```cpp
#include <hip/hip_runtime.h>
#include <hip/hip_cooperative_groups.h>
#include <cstdio>
#include <cstdint>
#include <cmath>
namespace cg = cooperative_groups;
#ifndef PHM
#define PHM 63
#endif
namespace pg8 {
#define PG8_LAS __attribute__((address_space(3)))
typedef unsigned short bf16_t;
typedef short bf16x8 __attribute__((ext_vector_type(8)));
typedef float f32x4 __attribute__((ext_vector_type(4)));
typedef unsigned u32x4 __attribute__((ext_vector_type(4)));
constexpr int BM = 256, BK = 64, HALF = 128, HTB = HALF * BK * 2  , STAGE_BYTES = 8 * HTB, NXCD = 8, WGM = 8;

__host__ __device__ __forceinline__ int lds_byte(int r, int c) { const int st = (r >> 4) * 2 + (c >> 5), rr = r & 15, cc = c & 31, ob = rr * 64 + cc * 2; return st * 1024 + (ob ^ (((ob >> 9) & 1) << 5)); }
__host__ __device__ __forceinline__ void stage_rc(int b, int& R, int& C) { const int st = b / 1024, sb = b % 1024, swz = sb ^ (((sb >> 9) & 1) << 5); R = (st >> 1) * 16 + swz / 64; C = (st & 1) * 32 + (swz % 64) / 2; }
__host__ __device__ __forceinline__ int perm32(int rho) { const int n = rho >> 4, i = rho & 15; return 8 * (i >> 2) + 4 * n + (i & 3); }

struct Unit { int pm, pn; };
struct Gemm { const bf16_t* A; const bf16_t* Bt; int M, N, K, lda; size_t kstepA; };

struct StaticOrder {
    int nM, nN, nwg, G, c;
    __host__ __device__ void init(int M, int N, int G_, int c_) { nM = M / BM; nN = N / BM; nwg = nM * nN; G = G_; c = c_; }
    __host__ __device__ bool next(int i, Unit& u) const {
        const long L = (long)i * G + c; if (L >= nwg) return false;
        int wgid = (int)L; { const int q = nwg / NXCD, r = nwg % NXCD, xcd = wgid % NXCD, off = wgid / NXCD; wgid = (xcd < r ? xcd * (q + 1) : r * (q + 1) + (xcd - r) * q) + off; }
        const int nig = WGM * nN, gid = wgid / nig, fm = gid * WGM, gsz = (nM - fm) < WGM ? (nM - fm) : WGM;
        u.pm = fm + ((wgid % nig) % gsz); u.pn = (wgid % nig) / gsz; return true;
    }
    __device__ __forceinline__ void a_ready(const Unit&) const {}
    __device__ __forceinline__ void done(const Unit&) const {}
};


typedef int i32x4_t __attribute__((ext_vector_type(4)));
typedef int i32x8_t __attribute__((ext_vector_type(8)));
__device__ __forceinline__ f32x4 mma_fp8(bf16x8 b0, bf16x8 b1, bf16x8 a0, bf16x8 a1, f32x4 c) {
    const i32x8_t B = __builtin_shufflevector(__builtin_bit_cast(i32x4_t, b0), __builtin_bit_cast(i32x4_t, b1), 0, 1, 2, 3, 4, 5, 6, 7);
    const i32x8_t A = __builtin_shufflevector(__builtin_bit_cast(i32x4_t, a0), __builtin_bit_cast(i32x4_t, a1), 0, 1, 2, 3, 4, 5, 6, 7);
    return __builtin_amdgcn_mfma_scale_f32_16x16x128_f8f6f4(B, A, c, 0, 0, 0, 0, 0, 0);
}
template <class Epi, class Sched, bool ALIGN_EPI = false, bool SP2 = false, bool FP8 = false>
__device__ __forceinline__ void gemm_phase(PG8_LAS unsigned char* lds, const Gemm g, const Sched& S, const Epi& E) {
    int tid_ = threadIdx.x; asm volatile("" : "+v"(tid_));
    const int tid = tid_, wid = __builtin_amdgcn_readfirstlane(tid >> 6), lane = tid & 63, wr = wid >> 2, wc = wid & 3, fr = lane & 15, fq = lane >> 4;
    const int K = g.K, nt = K / BK;
    unsigned voffA[2], voffB[2];
#pragma unroll
    for (int i = 0; i < 2; ++i) { int R, C; stage_rc(tid * 16 + i * 8192, R, C); const int Rb = Epi::PERM ? ((R & ~31) + perm32(R & 31)) : R;
        voffA[i] = (unsigned)(R * g.lda + C) * 2u; voffB[i] = (unsigned)(Rb * K + C) * 2u; }
    const size_t kstep = (size_t)(BK * 2), kstepA = g.kstepA;
    const size_t hstepA = (size_t)HALF * g.lda * 2, hstepB = (size_t)HALF * K * 2;
    const size_t tstepA = 2 * hstepA, tstepB = 2 * hstepB;
    const unsigned ldsw = (unsigned)wid * 1024u;
    const int aoff = lds_byte(wr * 64 + fr, fq * 8), boff = lds_byte(wc * 32 + fr, fq * 8);
#define PG8_SA(b, h) (((b) * 2 + (h)) * HTB)
#define PG8_SB(b, h) ((4 + (b) * 2 + (h)) * HTB)
#define PG8_STAGE(bufoff, gbase, voff) do { _Pragma("unroll") for (int _i = 0; _i < 2; ++_i) { unsigned vo_ = (voff)[_i]; asm volatile("" : "+v"(vo_));     \
        __builtin_amdgcn_global_load_lds((const unsigned*)((const char*)(gbase) + vo_), (PG8_LAS unsigned*)(lds + (bufoff) + ldsw + _i * 8192), 16, 0, 0); } } while (0)
#define PG8_LDA(dst, b, h) do { _Pragma("unroll") for (int m = 0; m < 4; ++m) _Pragma("unroll") for (int k = 0; k < 2; ++k) dst[m][k] = *(const PG8_LAS bf16x8*)(lds + PG8_SA(b, h) + aoff + m * 2048 + k * 1024); } while (0)
#define PG8_LDB(dst, b, h) do { _Pragma("unroll") for (int n = 0; n < 2; ++n) _Pragma("unroll") for (int k = 0; k < 2; ++k) dst[n][k] = *(const PG8_LAS bf16x8*)(lds + PG8_SB(b, h) + boff + n * 2048 + k * 1024); } while (0)
#define PG8_MMA(ai, bj, At, Bt) do { __builtin_amdgcn_s_setprio(1); _Pragma("unroll") for (int m = 0; m < 4; ++m) _Pragma("unroll") for (int n = 0; n < 2; ++n) { \
        if constexpr (FP8) acc[ai][bj][m][n] = mma_fp8(Bt[n][0], Bt[n][1], At[m][0], At[m][1], acc[ai][bj][m][n]); \
        else { _Pragma("unroll") for (int k = 0; k < 2; ++k) acc[ai][bj][m][n] = __builtin_amdgcn_mfma_f32_16x16x32_bf16(Bt[n][k], At[m][k], acc[ai][bj][m][n], 0, 0, 0); } } \
        __builtin_amdgcn_s_setprio(0); } while (0)
#define PG8_WAIT_V(n) asm volatile("s_waitcnt vmcnt(" #n ")" ::: "memory")
#define PG8_WAIT_L(n) asm volatile("s_waitcnt lgkmcnt(" #n ")" ::: "memory")
#define PG8_BAR __builtin_amdgcn_s_barrier()
#define PG8_SCHED __builtin_amdgcn_sched_barrier(0)
    Unit cur, nxt; int ui = 0;
    if (!S.next(0, cur)) return;
    f32x4 acc[2][2][4][2];
#pragma unroll
    for (int a = 0; a < 2; ++a)
#pragma unroll
        for (int b = 0; b < 2; ++b)
#pragma unroll
            for (int m = 0; m < 4; ++m)
#pragma unroll
                for (int n = 0; n < 2; ++n) acc[a][b][m][n] = (f32x4){0.f, 0.f, 0.f, 0.f};
    bf16x8 At[4][2], B0[2][2], B1[2][2];
    const char* cA = (const char*)g.A + (size_t)cur.pm * tstepA; const char* cB = (const char*)g.Bt + (size_t)cur.pn * tstepB;
    S.a_ready(cur);
    if constexpr (SP2) {
        PG8_STAGE(PG8_SB(0, 0), cB, voffB); PG8_STAGE(PG8_SB(0, 1), cB + hstepB, voffB); PG8_STAGE(PG8_SA(0, 0), cA, voffA); PG8_STAGE(PG8_SA(0, 1), cA + hstepA, voffA);
        if (wr == 1) PG8_BAR;
        PG8_WAIT_V(2); PG8_BAR;
        PG8_STAGE(PG8_SB(1, 0), cB + kstep, voffB); PG8_STAGE(PG8_SA(1, 0), cA + kstepA, voffA); PG8_STAGE(PG8_SB(1, 1), cB + hstepB + kstep, voffB);
        PG8_WAIT_V(6); PG8_BAR;
    } else {
        PG8_STAGE(PG8_SB(0, 0), cB, voffB); PG8_STAGE(PG8_SA(0, 0), cA, voffA); PG8_STAGE(PG8_SB(0, 1), cB + hstepB, voffB); PG8_STAGE(PG8_SA(0, 1), cA + hstepA, voffA);
        if (wr == 1) PG8_BAR;
        PG8_WAIT_V(4); PG8_BAR;
        PG8_STAGE(PG8_SB(1, 0), cB + kstep, voffB); PG8_STAGE(PG8_SA(1, 0), cA + kstepA, voffA); PG8_STAGE(PG8_SB(1, 1), cB + hstepB + kstep, voffB);
        PG8_WAIT_V(6); PG8_BAR;
    }
    for (;;) {
        const bool has_next = S.next(ui + 1, nxt);
        const char* nA = has_next ? (const char*)g.A + (size_t)nxt.pm * tstepA : cA; const char* nB = has_next ? (const char*)g.Bt + (size_t)nxt.pn * tstepB : cB;
#pragma unroll 1
        for (int t = 0; t < nt; t += 2) {
            const bool last = (t == nt - 2);
            const char* a1 = cA + (size_t)(t + 1) * kstepA;
            const char* a2 = last ? nA : cA + (size_t)(t + 2) * kstepA; const char* b2 = last ? nB : cB + (size_t)(t + 2) * kstep;
            const char* a3 = a2 + kstepA; const char* b3 = b2 + kstep;
            if (last && has_next) S.a_ready(nxt);
            if constexpr (SP2) {
            PG8_LDB(B0, 0, 0); PG8_LDB(B1, 0, 1); PG8_SCHED; PG8_LDA(At, 0, 0); PG8_STAGE(PG8_SA(1, 1), a1 + hstepA, voffA);
            PG8_WAIT_V(8); PG8_WAIT_L(0); PG8_BAR; PG8_MMA(0, 0, At, B0); PG8_MMA(0, 1, At, B1); PG8_BAR; PG8_SCHED;
            PG8_LDA(At, 0, 1); PG8_STAGE(PG8_SB(0, 0), b2, voffB); PG8_STAGE(PG8_SB(0, 1), b2 + hstepB, voffB); PG8_STAGE(PG8_SA(0, 0), a2, voffA);
            PG8_WAIT_V(8); PG8_WAIT_L(0); PG8_BAR; PG8_MMA(1, 0, At, B0); PG8_MMA(1, 1, At, B1); PG8_BAR; PG8_SCHED;
            PG8_LDB(B0, 1, 0); PG8_LDB(B1, 1, 1); PG8_SCHED; PG8_LDA(At, 1, 0); PG8_STAGE(PG8_SA(0, 1), a2 + hstepA, voffA);
            PG8_WAIT_V(8); PG8_WAIT_L(0); PG8_BAR; PG8_MMA(0, 0, At, B0); PG8_MMA(0, 1, At, B1); PG8_BAR; PG8_SCHED;
            PG8_LDA(At, 1, 1); PG8_STAGE(PG8_SB(1, 0), b3, voffB); PG8_STAGE(PG8_SB(1, 1), b3 + hstepB, voffB); PG8_STAGE(PG8_SA(1, 0), a3, voffA);
            PG8_WAIT_V(8); PG8_WAIT_L(0); PG8_BAR; PG8_MMA(1, 0, At, B0); PG8_MMA(1, 1, At, B1); PG8_BAR; PG8_SCHED;
            } else {
            PG8_LDB(B0, 0, 0); PG8_SCHED; PG8_LDA(At, 0, 0); PG8_STAGE(PG8_SA(1, 1), a1 + hstepA, voffA);
            PG8_WAIT_L(8); PG8_BAR; PG8_WAIT_L(0); PG8_MMA(0, 0, At, B0); PG8_BAR; PG8_SCHED;
            PG8_LDB(B1, 0, 1); PG8_STAGE(PG8_SB(0, 0), b2, voffB);
            PG8_BAR; PG8_WAIT_L(0); PG8_MMA(0, 1, At, B1); PG8_BAR;
            PG8_LDA(At, 0, 1); PG8_STAGE(PG8_SA(0, 0), a2, voffA);
            PG8_BAR; PG8_WAIT_L(0); PG8_MMA(1, 0, At, B0); PG8_BAR; PG8_SCHED;
            PG8_STAGE(PG8_SB(0, 1), b2 + hstepB, voffB);
            PG8_WAIT_V(6); PG8_BAR; PG8_MMA(1, 1, At, B1); PG8_BAR;
            PG8_LDB(B0, 1, 0); PG8_SCHED; PG8_LDA(At, 1, 0); PG8_STAGE(PG8_SA(0, 1), a2 + hstepA, voffA);
            PG8_WAIT_L(8); PG8_BAR; PG8_WAIT_L(0); PG8_MMA(0, 0, At, B0); PG8_BAR; PG8_SCHED;
            PG8_LDB(B1, 1, 1); PG8_STAGE(PG8_SB(1, 0), b3, voffB);
            PG8_BAR; PG8_WAIT_L(0); PG8_MMA(0, 1, At, B1); PG8_BAR;
            PG8_LDA(At, 1, 1); PG8_STAGE(PG8_SA(1, 0), a3, voffA);
            PG8_BAR; PG8_WAIT_L(0); PG8_MMA(1, 0, At, B0); PG8_BAR; PG8_SCHED;
            PG8_STAGE(PG8_SB(1, 1), b3 + hstepB, voffB);
            PG8_WAIT_V(6); PG8_BAR; PG8_MMA(1, 1, At, B1); PG8_BAR;
            }
        }
        if constexpr (ALIGN_EPI) { if (wr == 0) PG8_BAR; }
        if constexpr (!Epi::AFTER_DRAIN) { E(acc, cur, wr, wc, fr, fq); S.done(cur); }
        if (!has_next) break;
#pragma unroll
        for (int a = 0; a < 2; ++a)
#pragma unroll
            for (int b = 0; b < 2; ++b)
#pragma unroll
                for (int m = 0; m < 4; ++m)
#pragma unroll
                    for (int n = 0; n < 2; ++n) acc[a][b][m][n] = (f32x4){0.f, 0.f, 0.f, 0.f};
        cur = nxt; cA = nA; cB = nB; ++ui;
        if constexpr (ALIGN_EPI) { if (wr == 1) PG8_BAR; }
    }
    PG8_WAIT_V(0);
    if constexpr (!ALIGN_EPI) { if (wr == 0) PG8_BAR; }
    PG8_BAR;
    if constexpr (Epi::AFTER_DRAIN) { E.fused(acc, cur, wr, wc, fr, fq, lds, wid, lane); S.done(cur); }
#undef PG8_SA
#undef PG8_SB
#undef PG8_STAGE
#undef PG8_LDA
#undef PG8_LDB
#undef PG8_MMA
#undef PG8_WAIT_V
#undef PG8_WAIT_L
#undef PG8_BAR
#undef PG8_SCHED
}
}

using pg8::bf16_t; using pg8::bf16x8; using pg8::f32x4; using pg8::u32x4;
#define LAS __attribute__((address_space(3)))
typedef float f32x16 __attribute__((ext_vector_type(16)));
typedef float f32x2 __attribute__((ext_vector_type(2)));
typedef unsigned u32x2 __attribute__((ext_vector_type(2)));
typedef short s16x4 __attribute__((ext_vector_type(4)));
typedef __bf16 bf16x2_t __attribute__((ext_vector_type(2)));
#define MFMA32(a, b, c) __builtin_amdgcn_mfma_f32_32x32x16_bf16((a), (b), (c), 0, 0, 0)

__device__ __forceinline__ unsigned pk_bf16(float lo, float hi) { f32x2 v = {lo, hi}; bf16x2_t b = __builtin_convertvector(v, bf16x2_t); return __builtin_bit_cast(unsigned, b); }
__device__ __forceinline__ float bf_lo(unsigned w) { return __uint_as_float(w << 16); }
__device__ __forceinline__ float bf_hi(unsigned w) { return __uint_as_float(w & 0xffff0000u); }
__device__ __forceinline__ void st4bf(bf16_t* p, f32x4 v) { u32x2 w; w.x = pk_bf16(v[0], v[1]); w.y = pk_bf16(v[2], v[3]); *(u32x2*)p = w; }
__device__ __forceinline__ f32x4 ld4bf(const bf16_t* p) { const u32x2 w = *(const u32x2*)p; return (f32x4){bf_lo(w.x), bf_hi(w.x), bf_lo(w.y), bf_hi(w.y)}; }
__device__ __forceinline__ int crow(int r, int hi) { return (r & 3) + 8 * (r >> 2) + 4 * hi; }
__device__ __forceinline__ float x32_sum(float x) { auto rr = __builtin_amdgcn_permlane32_swap(__float_as_uint(x), __float_as_uint(x), false, false); return __uint_as_float(rr[0]) + __uint_as_float(rr[1]); }
__device__ __forceinline__ float x32_max(float x) { auto rr = __builtin_amdgcn_permlane32_swap(__float_as_uint(x), __float_as_uint(x), false, false); return fmaxf(__uint_as_float(rr[0]), __uint_as_float(rr[1])); }
__device__ __forceinline__ float x32_other(float x, bool lower_half) { auto rr = __builtin_amdgcn_permlane32_swap(__float_as_uint(x), __float_as_uint(x), false, false); return lower_half ? __uint_as_float(rr[1]) : __uint_as_float(rr[0]); }
__device__ __forceinline__ float x16_other(float x, bool even_row) { auto rr = __builtin_amdgcn_permlane16_swap(__float_as_uint(x), __float_as_uint(x), false, false); return even_row ? __uint_as_float(rr[1]) : __uint_as_float(rr[0]); }
__device__ __forceinline__ float x16_sum(float x) { auto rr = __builtin_amdgcn_permlane16_swap(__float_as_uint(x), __float_as_uint(x), false, false); return __uint_as_float(rr[0]) + __uint_as_float(rr[1]); }
template <int XM> __device__ __forceinline__ float swz_xor(float x) { return __int_as_float(__builtin_amdgcn_ds_swizzle(__float_as_int(x), (XM << 10) | 0x1f)); }
__device__ __forceinline__ float wave_sum(float v) {
    v += swz_xor<1>(v); v += swz_xor<2>(v); v += swz_xor<4>(v); v += swz_xor<8>(v); v += swz_xor<16>(v);
    return x32_sum(v);
}
#define LDS_WAIT() asm volatile("s_waitcnt lgkmcnt(0)" ::: "memory")
#define LDS_BARRIER() asm volatile("s_waitcnt lgkmcnt(0)\n\ts_barrier" ::: "memory")

constexpr int DM = 1024, SEQ = 4096, NSEQ = 24, NPSEQ = 16;
constexpr int GS = 8, TG = GS * SEQ, NG = NSEQ / GS;
constexpr int NIN = 8096, NINP = 8192;
constexpr int C_QA = 0, C_KA = 1536, C_VA = 3072, C_GA = 4608, C_QL = 5120, C_KVL = 5376, C_KR = 5504, C_GB = 5536, C_MGA = 6048, C_MGB = 7072;
constexpr float EPS = 1e-6f;
constexpr size_t ZBLK = (size_t)GS * SEQ * 64;
__host__ __device__ __forceinline__ size_t zoff(size_t row, int col) { return (size_t)(col >> 6) * ZBLK + row * 64 + (size_t)(col & 63); }
struct TileRuns { int a0, a1, b0, b1;
    __host__ __device__ constexpr int count() const { return (a1 - a0) + (b1 - b0); }
    __host__ __device__ constexpr int map(int p) const { return p < (a1 - a0) ? a0 + p : b0 + (p - (a1 - a0)); }
    __host__ __device__ constexpr int inv(int t) const { return (t >= a0 && t < a1) ? t - a0 : ((t >= b0 && t < b1) ? (a1 - a0) + (t - b0) : -1); } };
#ifndef F8_VARIANT
#define F8_VARIANT 18
#endif
#if F8_VARIANT == 18
constexpr TileRuns RUNS_F8{12, 18, 20, 32}, RUNS_B16{0, 12, 18, 20};
#else
constexpr TileRuns RUNS_F8{20, 32, 32, 32}, RUNS_B16{0, 20, 20, 20};
#endif
static_assert(RUNS_F8.count() + RUNS_B16.count() == 32, "tile sets");
constexpr float F8_SA = 8.0f, F8_SB = 32.0f, F8_DQ = 1.0f / (F8_SA * F8_SB);
constexpr float LOG2E = 1.4426950408889634f;
constexpr float QA_SCALE = 0.125f * LOG2E;
constexpr float QB_SCALE = 0.10206207261596577f * LOG2E;
static_assert(NPSEQ % GS == 0 && NSEQ % GS == 0, "groups must not straddle the two inputs");

constexpr size_t MiB = 1u << 20;
constexpr size_t WS_Z = 0;
constexpr size_t WS_HB = 512 * MiB;
constexpr size_t WS_QB = 576 * MiB;
constexpr size_t WS_KVB = 624 * MiB;
constexpr size_t WS_UA = 688 * MiB;
constexpr size_t WS_UB = 720 * MiB;
constexpr size_t WS_MG = 752 * MiB;
constexpr size_t WS_LSE = 816 * MiB;
constexpr size_t WS_SSQ = 820 * MiB;
constexpr size_t WS_WIN = 824 * MiB;
constexpr size_t WS_WQ = 840 * MiB;
constexpr size_t WS_WKV = 841 * MiB;
constexpr size_t WS_WOA = 842 * MiB;
constexpr size_t WS_WOB = 843 * MiB;
constexpr size_t WS_WO = 844 * MiB;
constexpr size_t WS_TABA = 846 * MiB;
constexpr size_t WS_TABB = 847 * MiB;
constexpr size_t WS_OA = 848 * MiB;
constexpr size_t WS_BAR = 944 * MiB;
constexpr size_t WS_HB8 = 946 * MiB;
constexpr size_t WS_END = 978 * MiB;
static_assert((size_t)TG * NINP * 2 <= WS_HB && (size_t)TG * 24 * 4 <= 4 * MiB, "ws map");

constexpr int LDS_BYTES = 131072 + 1024;
constexpr int NPH = 6;
constexpr int PH_TOTAL = NG * NPH + 1;

struct Args { const float* in[12]; float* out; unsigned char* ws; int ph_lo, ph_hi; };

__device__ __forceinline__ float sigmoidf_(float x) { return __builtin_amdgcn_rcpf(1.0f + __builtin_amdgcn_exp2f(x * -1.4426950408889634f)); }

struct EpiZ {
    static constexpr bool PERM = true, AFTER_DRAIN = false;
    bf16_t* Z; float* ssq; const float* tabA; const float* tabB; TileRuns tr; float dq;
    __device__ __forceinline__ void operator()(const f32x4 (&acc)[2][2][4][2], const pg8::Unit& u, int wr, int wc, int fr, int fq) const {
        { int t_ = threadIdx.x; asm volatile("" : "+v"(t_)); fr = t_ & 15; fq = (t_ >> 4) & 3; }
        const int row0 = u.pm * 256 + wr * 64 + fr;
        const __amdgpu_buffer_rsrc_t zrs = __builtin_amdgcn_make_buffer_rsrc(Z, 0, 0x7fffffff, 0x00020000);
#pragma unroll
        for (int bj = 0; bj < 2; ++bj) {
            const int cg0 = tr.map(u.pn) * 256 + bj * 128 + wc * 32;
            if (cg0 >= NIN) continue;
            int kind;
            if (cg0 < C_KA) kind = ((cg0 & 63) == 0) ? 1 : 2;
            else if (cg0 < C_VA) kind = ((cg0 & 63) == 0) ? 3 : 0;
            else if (cg0 < C_GA) kind = 0;
            else if (cg0 < C_QL) kind = 4;
            else if (cg0 < C_KVL) kind = 7;
            else if (cg0 < C_KR) kind = 8;
            else if (cg0 < C_GB) kind = 6;
            else if (cg0 < C_MGA) kind = 4;
            else kind = 5;
#pragma unroll
            for (int ai = 0; ai < 2; ++ai)
#pragma unroll
                for (int m = 0; m < 4; ++m) {
                    const int row = row0 + ai * 128 + m * 16;
                    f32x4 v0 = acc[ai][bj][m][0] * dq, v1 = acc[ai][bj][m][1] * dq;
                    if (kind == 1 || kind == 3) {
                        const int pos = row & (SEQ - 1);
                        const f32x4 ca = *(const f32x4*)(tabA + pos * 16), cb = *(const f32x4*)(tabA + pos * 16 + 4), sa = *(const f32x4*)(tabA + pos * 16 + 8), sb = *(const f32x4*)(tabA + pos * 16 + 12);
                        f32x4 pa, pb;
#pragma unroll
                        for (int e = 0; e < 4; ++e) { pa[e] = x16_other(v0[e], (fq & 1) == 0); pb[e] = x16_other(v1[e], (fq & 1) == 0); }
                        if (fq == 0) { v0 = v0 * ca - pa * sa; v1 = v1 * cb - pb * sb; }
                        else if (fq == 1) { v0 = v0 * ca + pa * sa; v1 = v1 * cb + pb * sb; }
                        if (kind == 1) { v0 = v0 * QA_SCALE; v1 = v1 * QA_SCALE; }
                    } else if (kind == 2) { v0 = v0 * QA_SCALE; v1 = v1 * QA_SCALE; }
                    else if (kind == 4) {
#pragma unroll
                        for (int e = 0; e < 4; ++e) { v0[e] = v0[e] * sigmoidf_(v0[e]); v1[e] = v1[e] * sigmoidf_(v1[e]); }
                    } else if (kind == 5) {
#pragma unroll
                        for (int e = 0; e < 4; ++e) { v0[e] = sigmoidf_(v0[e]); v1[e] = sigmoidf_(v1[e]); }
                    } else if (kind == 6) {
                        const int pos = row & (SEQ - 1), i0 = 8 * (fq & 1);
                        const f32x4 ca = *(const f32x4*)(tabB + pos * 32 + i0), cb = *(const f32x4*)(tabB + pos * 32 + i0 + 4), sa = *(const f32x4*)(tabB + pos * 32 + 16 + i0), sb = *(const f32x4*)(tabB + pos * 32 + 16 + i0 + 4);
                        f32x4 pa, pb;
#pragma unroll
                        for (int e = 0; e < 4; ++e) { pa[e] = x32_other(v0[e], fq < 2); pb[e] = x32_other(v1[e], fq < 2); }
                        if (fq < 2) { v0 = v0 * ca - pa * sa; v1 = v1 * cb - pb * sb; }
                        else { v0 = v0 * ca + pa * sa; v1 = v1 * cb + pb * sb; }
                    } else if (kind == 7 || kind == 8) {
                        float s = 0.f;
#pragma unroll
                        for (int e = 0; e < 4; ++e) s += v0[e] * v0[e] + v1[e] * v1[e];
                        s = x16_sum(s); s = x32_sum(s);
                        if (fq == 0) atomicAdd(ssq + (size_t)row * 4 + (kind == 7 ? 0 : 1), s);
                    }
                    u32x4 w; w.x = pk_bf16(v0[0], v0[1]); w.y = pk_bf16(v0[2], v0[3]); w.z = pk_bf16(v1[0], v1[1]); w.w = pk_bf16(v1[2], v1[3]);
                    __builtin_amdgcn_raw_buffer_store_b128(w, zrs, (int)(zoff((size_t)row, cg0 + 8 * fq) * 2), 0, 16);
                }
        }
    }
};

__device__ __forceinline__ u32x4 pk8bf(const f32x4 a, const f32x4 b) { u32x4 w; w.x = pk_bf16(a[0], a[1]); w.y = pk_bf16(a[2], a[3]); w.z = pk_bf16(b[0], b[1]); w.w = pk_bf16(b[2], b[3]); return w; }
__device__ __forceinline__ f32x4 lo4(const u32x4 w) { return (f32x4){bf_lo(w.x), bf_hi(w.x), bf_lo(w.y), bf_hi(w.y)}; }
__device__ __forceinline__ f32x4 hi4(const u32x4 w) { return (f32x4){bf_lo(w.z), bf_hi(w.z), bf_lo(w.w), bf_hi(w.w)}; }

struct EpiQ {
    static constexpr bool PERM = true, AFTER_DRAIN = false;
    bf16_t* Q; const float* ssq; const float* tabB;
    __device__ __forceinline__ void operator()(const f32x4 (&acc)[2][2][4][2], const pg8::Unit& u, int wr, int wc, int fr, int fq) const {
        { int t_ = threadIdx.x; asm volatile("" : "+v"(t_)); fr = t_ & 15; fq = (t_ >> 4) & 3; }
        const int row0 = u.pm * 256 + wr * 64 + fr;
#pragma unroll
        for (int bj = 0; bj < 2; ++bj) {
            const int cg0 = u.pn * 256 + bj * 128 + wc * 32;
            const bool rope = (cg0 % 96) == 64;
#pragma unroll
            for (int ai = 0; ai < 2; ++ai)
#pragma unroll
                for (int m = 0; m < 4; ++m) {
                    const int row = row0 + ai * 128 + m * 16;
                    const float rs = rsqrtf(ssq[(size_t)row * 4 + 0] * (1.0f / 256.0f) + EPS) * QB_SCALE;
                    f32x4 v0 = acc[ai][bj][m][0] * rs, v1 = acc[ai][bj][m][1] * rs;
                    if (rope) {
                        const int pos = row & (SEQ - 1), i0 = 8 * (fq & 1);
                        const f32x4 ca = *(const f32x4*)(tabB + pos * 32 + i0), cb = *(const f32x4*)(tabB + pos * 32 + i0 + 4), sa = *(const f32x4*)(tabB + pos * 32 + 16 + i0), sb = *(const f32x4*)(tabB + pos * 32 + 16 + i0 + 4);
                        f32x4 pa, pb;
#pragma unroll
                        for (int e = 0; e < 4; ++e) { pa[e] = x32_other(v0[e], fq < 2); pb[e] = x32_other(v1[e], fq < 2); }
                        if (fq < 2) { v0 = v0 * ca - pa * sa; v1 = v1 * cb - pb * sb; }
                        else { v0 = v0 * ca + pa * sa; v1 = v1 * cb + pb * sb; }
                    }
                    *(u32x4*)(Q + (size_t)row * 768 + cg0 + 8 * fq) = pk8bf(v0, v1);
                }
        }
    }
};

struct EpiKV {
    static constexpr bool PERM = true, AFTER_DRAIN = false;
    bf16_t* KV; const float* ssq;
    __device__ __forceinline__ void operator()(const f32x4 (&acc)[2][2][4][2], const pg8::Unit& u, int wr, int wc, int fr, int fq) const {
        { int t_ = threadIdx.x; asm volatile("" : "+v"(t_)); fr = t_ & 15; fq = (t_ >> 4) & 3; }
        const int row0 = u.pm * 256 + wr * 64 + fr;
#pragma unroll
        for (int ai = 0; ai < 2; ++ai)
#pragma unroll
            for (int m = 0; m < 4; ++m) {
                const int row = row0 + ai * 128 + m * 16;
                const float rs = rsqrtf(ssq[(size_t)row * 4 + 1] * (1.0f / 128.0f) + EPS);
#pragma unroll
                for (int bj = 0; bj < 2; ++bj)
                    *(u32x4*)(KV + (size_t)row * 1024 + u.pn * 256 + bj * 128 + wc * 32 + 8 * fq) = pk8bf(acc[ai][bj][m][0] * rs, acc[ai][bj][m][1] * rs);
            }
    }
};

template <bool ADD> struct EpiMerge {
    static constexpr bool PERM = true, AFTER_DRAIN = false;
    bf16_t* MG; const bf16_t* Zg; int gcol;
    __device__ __forceinline__ void operator()(const f32x4 (&acc)[2][2][4][2], const pg8::Unit& u, int wr, int wc, int fr, int fq) const {
        { int t_ = threadIdx.x; asm volatile("" : "+v"(t_)); fr = t_ & 15; fq = (t_ >> 4) & 3; }
        const int row0 = u.pm * 256 + wr * 64 + fr, col0 = u.pn * 256 + wc * 32 + 8 * fq;
#pragma unroll
        for (int ai = 0; ai < 2; ++ai) {
            u32x4 gt[4][2], mo[4][2];
#pragma unroll
            for (int m = 0; m < 4; ++m)
#pragma unroll
                for (int bj = 0; bj < 2; ++bj) {
                    const size_t row = (size_t)(row0 + ai * 128 + m * 16); const int col = col0 + bj * 128;
                    gt[m][bj] = *(const u32x4*)(Zg + zoff(row, gcol + col));
                    if (ADD) mo[m][bj] = *(const u32x4*)(MG + row * 1024 + col);
                }
#pragma unroll
            for (int m = 0; m < 4; ++m)
#pragma unroll
                for (int bj = 0; bj < 2; ++bj) {
                    const size_t row = (size_t)(row0 + ai * 128 + m * 16); const int col = col0 + bj * 128;
                    f32x4 v0 = lo4(gt[m][bj]) * acc[ai][bj][m][0], v1 = hi4(gt[m][bj]) * acc[ai][bj][m][1];
                    if (ADD) { v0 = v0 + lo4(mo[m][bj]); v1 = v1 + hi4(mo[m][bj]); }
                    *(u32x4*)(MG + row * 1024 + col) = pk8bf(v0, v1);
                }
            asm volatile("" ::: "memory");
        }
    }
};

struct EpiDelta {
    static constexpr bool PERM = true, AFTER_DRAIN = false;
    bf16_t* Dl;
    __device__ __forceinline__ void operator()(const f32x4 (&acc)[2][2][4][2], const pg8::Unit& u, int wr, int wc, int fr, int fq) const {
        { int t_ = threadIdx.x; asm volatile("" : "+v"(t_)); fr = t_ & 15; fq = (t_ >> 4) & 3; }
        const int row0 = u.pm * 256 + wr * 64 + fr;
#pragma unroll
        for (int ai = 0; ai < 2; ++ai)
#pragma unroll
            for (int m = 0; m < 4; ++m) {
                const int row = row0 + ai * 128 + m * 16;
#pragma unroll
                for (int bj = 0; bj < 2; ++bj)
                    *(u32x4*)(Dl + (size_t)row * DM + u.pn * 256 + bj * 128 + wc * 32 + 8 * fq) = pk8bf(acc[ai][bj][m][0], acc[ai][bj][m][1]);
            }
    }
};

constexpr int KSTR_B = 208, KSTR_A = 144, VSTR = 192;
constexpr int AT_KB = 128 * KSTR_B, AT_VB = 128 * VSTR;
constexpr int AT_K = 0, AT_V = 2 * AT_KB, AT_WSF = AT_V + 2 * AT_VB, AT_END = AT_WSF + 8 * 256;
constexpr int AT_OST = 0, AT_OSTB = 32 * 144;
static_assert(AT_END <= 131072 && 8 * AT_OSTB <= 2 * AT_KB, "attention LDS");
constexpr float ATT_THR = 5.0f;
typedef short v4i16_t __attribute__((ext_vector_type(4)));
__device__ __forceinline__ float max3f(float a, float b, float c) { float r; asm("v_max3_f32 %0, %1, %2, %3" : "=v"(r) : "v"(a), "v"(b), "v"(c)); return r; }
__device__ __forceinline__ s16x4 vtr(const LAS unsigned char* p) { return __builtin_bit_cast(s16x4, __builtin_amdgcn_ds_read_tr16_b64_v4i16((LAS v4i16_t*)p)); }

template <int NS, int S0 = 0, int S1 = NS>
__device__ __forceinline__ void load_kfrags(bf16x8 (&kf)[2 * NS], const LAS unsigned char* kb, const int kstr, const int lane) {
    const LAS unsigned char* kp = kb + (lane & 31) * kstr + (lane >> 5) * 16;
#pragma unroll
    for (int s = S0; s < S1; ++s) { kf[2 * s] = *(const LAS bf16x8*)(kp + s * 32); kf[2 * s + 1] = *(const LAS bf16x8*)(kp + 32 * kstr + s * 32); }
}

template <int NS, bool MASK, bool PRE, bool HALF_IN>
__device__ __forceinline__ void attn_tile(bf16x8 (&kf)[2 * NS], const LAS unsigned char* kb_cur, const LAS unsigned char* kb_next, const int kstr, const LAS unsigned char* vb, const bf16x8 (&qf)[NS],
                                          f32x16 (&o)[2], f32x16& negm, float& m, float& l, bool& seen, LAS float* wsf, const int lane, const int dm  ) {
    const int r32 = lane & 31, hi = lane >> 5;
    if (HALF_IN) load_kfrags<NS, NS / 2, NS>(kf, kb_cur, kstr, lane); else load_kfrags<NS, 0, NS>(kf, kb_cur, kstr, lane);
    f32x16 p0 = MFMA32(kf[0], qf[0], negm), p1 = MFMA32(kf[1], qf[0], negm);
#pragma unroll
    for (int s = 1; s < NS; ++s) { p0 = MFMA32(kf[2 * s], qf[s], p0); p1 = MFMA32(kf[2 * s + 1], qf[s], p1); }
    bf16x8 vf[8];
    const int q4 = (lane & 15) >> 2, p4 = lane & 3, b16 = (lane >> 4) & 1;
    const LAS unsigned char* vp = vb + (4 * hi + q4) * VSTR + b16 * 32 + p4 * 8;
#pragma unroll
    for (int blk = 0; blk < 2; ++blk)
#pragma unroll
        for (int s = 0; s < 2; ++s) {
            const LAS unsigned char* a = vp + (32 * blk + 16 * s) * VSTR;
            const s16x4 lo = vtr(a), h4 = vtr(a + 8 * VSTR);
            vf[blk * 2 + s] = (bf16x8){lo[0], lo[1], lo[2], lo[3], h4[0], h4[1], h4[2], h4[3]};
        }
    if (PRE) load_kfrags<NS, 0, NS / 2>(kf, kb_next, kstr, lane);
    if (MASK) {
#pragma unroll
        for (int r = 0; r < 16; ++r) { const int d0 = dm + crow(r, hi), d1 = d0 + 32;
            if (d0 < -64 || d0 > 64) p0[r] = -INFINITY;
            if (d1 < -64 || d1 > 64) p1[r] = -INFINITY; }
    }
    asm volatile("s_nop 15\n\ts_nop 7" : "+v"(p0), "+v"(p1));
    float rm;
    { float ma = max3f(p0[0], p0[1], p1[0]), mb = max3f(p0[2], p0[3], p1[1]); ma = max3f(ma, p1[2], p1[3]);
#pragma unroll
      for (int r = 4; r < 16; r += 4) { ma = max3f(ma, p0[r], p0[r + 1]); mb = max3f(mb, p0[r + 2], p0[r + 3]); ma = max3f(ma, p1[r], p1[r + 1]); mb = max3f(mb, p1[r + 2], p1[r + 3]); }
      rm = max3f(ma, mb, mb); }
    rm = x32_max(rm);
    const bool valid = rm > -INFINITY;
    const bool upd = (rm > ATT_THR) || (!seen && valid);
    if (__any(upd)) {
        const float d = upd ? rm : 0.f;
        const float alpha = (seen && upd) ? __builtin_amdgcn_exp2f(-d) : 1.f;
        m += d; l *= alpha;
#pragma unroll
        for (int r = 0; r < 16; ++r) { p0[r] -= d; p1[r] -= d; negm[r] = -m; }
        if (hi == 0) wsf[r32] = alpha;
#pragma unroll
        for (int g4 = 0; g4 < 4; ++g4) { const f32x4 a4 = *(const LAS f32x4*)(wsf + 8 * g4 + 4 * hi);
#pragma unroll
            for (int j = 0; j < 4; ++j) { o[0][4 * g4 + j] *= a4[j]; o[1][4 * g4 + j] *= a4[j]; } }
    }
    seen = seen || valid;
    float sum = 0.f;
#pragma unroll
    for (int r = 0; r < 16; ++r) { p0[r] = __builtin_amdgcn_exp2f(p0[r]); p1[r] = __builtin_amdgcn_exp2f(p1[r]); sum += p0[r] + p1[r]; }
    l += sum;
    bf16x8 pa[2][2];
#pragma unroll
    for (int s = 0; s < 2; ++s) {
        u32x4 w0, w1;
#pragma unroll
        for (int j = 0; j < 4; ++j) { w0[j] = pk_bf16(p0[8 * s + 2 * j], p0[8 * s + 2 * j + 1]); w1[j] = pk_bf16(p1[8 * s + 2 * j], p1[8 * s + 2 * j + 1]); }
        pa[0][s] = __builtin_bit_cast(bf16x8, w0); pa[1][s] = __builtin_bit_cast(bf16x8, w1);
    }
#pragma unroll
    for (int blk = 0; blk < 2; ++blk)
#pragma unroll
        for (int s = 0; s < 2; ++s) {
            const LAS unsigned char* a = vp + (32 * blk + 16 * s) * VSTR + 64;
            const s16x4 lo = vtr(a), h4 = vtr(a + 8 * VSTR);
            vf[4 + blk * 2 + s] = (bf16x8){lo[0], lo[1], lo[2], lo[3], h4[0], h4[1], h4[2], h4[3]};
        }
#pragma unroll
    for (int dd = 0; dd < 2; ++dd)
#pragma unroll
        for (int blk = 0; blk < 2; ++blk)
#pragma unroll
            for (int s = 0; s < 2; ++s) o[dd] = MFMA32(pa[blk][s], vf[dd * 4 + blk * 2 + s], o[dd]);
}

template <bool GATE>
__device__ __forceinline__ float attn_epilogue(const f32x16 (&o)[2], const float l, LAS float* wsf, LAS unsigned char* ost, const int lane,
                                               bf16_t* obase, const size_t ostride, const bf16_t* gbase, const size_t gstride) {
    const int r32 = lane & 31, hi = lane >> 5;
    const float lt = x32_sum(l);
    const float inv = 1.0f / lt;
    if (hi == 0) wsf[r32] = inv;
#pragma unroll
    for (int g4 = 0; g4 < 4; ++g4) { const f32x4 iv = *(const LAS f32x4*)(wsf + 8 * g4 + 4 * hi);
#pragma unroll
        for (int j = 0; j < 4; ++j) { const int row = 8 * g4 + 4 * hi + j;
#pragma unroll
            for (int dd = 0; dd < 2; ++dd) { const float v = o[dd][4 * g4 + j] * iv[j];
                *(LAS unsigned short*)(ost + row * 144 + (dd * 32 + r32) * 2) = (unsigned short)(pk_bf16(v, v) & 0xffffu); } } }
    LDS_WAIT();
#pragma unroll
    for (int i = 0; i < 4; ++i) { const int row = i * 8 + (lane >> 3), ch = lane & 7;
        u32x4 v = *(const LAS u32x4*)(ost + row * 144 + ch * 16);
        if (GATE) { const u32x4 gt = *(const u32x4*)(gbase + (size_t)row * gstride);
#pragma unroll
            for (int w = 0; w < 4; ++w) v[w] = pk_bf16(bf_lo(v[w]) * bf_lo(gt[w]), bf_hi(v[w]) * bf_hi(gt[w])); }
        *(u32x4*)(obase + (size_t)row * ostride + ch * 8) = v; }
    LDS_WAIT();
    return lt;
}

__device__ __forceinline__ void mla_unit(LAS unsigned char* lds, const bf16_t* QB, const bf16_t* KVB, const bf16_t* Z, bf16_t* UB, const int sb, const int h, const int qb) {
    int tid_ = threadIdx.x; asm volatile("" : "+v"(tid_));
    const int tid = tid_, lane = tid & 63, wid = __builtin_amdgcn_readfirstlane(tid >> 6), r32 = lane & 31, hi = lane >> 5;
    const int tok0 = sb * SEQ;
    const int qrow = tok0 + qb * 256 + wid * 32 + r32;
    bf16x8 qf[6];
#pragma unroll
    for (int s = 0; s < 6; ++s) qf[s] = *(const bf16x8*)(QB + (size_t)qrow * 768 + h * 96 + s * 16 + hi * 8);
    f32x16 o[2];
#pragma unroll
    for (int r = 0; r < 16; ++r) { o[0][r] = 0.f; o[1][r] = 0.f; }
    float m = 0.f, l = 0.f; bool seen = false;
    f32x16 negm;
#pragma unroll
    for (int r = 0; r < 16; ++r) negm[r] = 0.f;
    bf16x8 kf[12];
    LAS float* wsf = (LAS float*)(lds + AT_WSF + wid * 256);
    const int kk = tid >> 3, c = tid & 7, kk2 = tid >> 2, c2 = tid & 3;
    const bf16_t* kvsrc = KVB + (size_t)(tok0 + kk) * 1024 + h * 128 + c * 8;
    const bf16_t* pesrc = Z + zoff((size_t)(tok0 + kk2), C_KR + c2 * 8);
    u32x4 rk0 = *(const u32x4*)kvsrc, rv0 = *(const u32x4*)(kvsrc + 64), rk1 = *(const u32x4*)(kvsrc + 64 * 1024), rv1 = *(const u32x4*)(kvsrc + 64 * 1024 + 64), rp = *(const u32x4*)pesrc;
    constexpr int NST = SEQ / 128;
    for (int st = 0; st < NST; ++st) {
        LAS unsigned char* kbuf = lds + AT_K + (st & 1) * AT_KB;
        LAS unsigned char* vbuf = lds + AT_V + (st & 1) * AT_VB;
        *(LAS u32x4*)(kbuf + kk * KSTR_B + c * 16) = rk0; *(LAS u32x4*)(kbuf + (kk + 64) * KSTR_B + c * 16) = rk1;
        *(LAS u32x4*)(vbuf + kk * VSTR + c * 16) = rv0; *(LAS u32x4*)(vbuf + (kk + 64) * VSTR + c * 16) = rv1;
        *(LAS u32x4*)(kbuf + kk2 * KSTR_B + 128 + c2 * 16) = rp;
        LDS_BARRIER();
        if (st + 1 < NST) {
            const size_t adv = (size_t)(st + 1) * 128;
            rk0 = *(const u32x4*)(kvsrc + adv * 1024); rv0 = *(const u32x4*)(kvsrc + adv * 1024 + 64);
            rk1 = *(const u32x4*)(kvsrc + (adv + 64) * 1024); rv1 = *(const u32x4*)(kvsrc + (adv + 64) * 1024 + 64);
            rp = *(const u32x4*)(pesrc + adv * 64);
        }
        attn_tile<6, false, true, false>(kf, kbuf, kbuf + 64 * KSTR_B, KSTR_B, vbuf, qf, o, negm, m, l, seen, wsf, lane, 0);
        attn_tile<6, false, false, true>(kf, kbuf + 64 * KSTR_B, kbuf, KSTR_B, vbuf + 64 * VSTR, qf, o, negm, m, l, seen, wsf, lane, 0);
    }
    LDS_BARRIER();
    const size_t orow = (size_t)(tok0 + qb * 256 + wid * 32);
    attn_epilogue<true>(o, l, wsf, lds + AT_OST + wid * AT_OSTB, lane, UB + orow * 512 + h * 64, 512, Z + zoff(orow, C_GB + h * 64 + (lane & 7) * 8), 64);
    LDS_BARRIER();
}

__device__ __forceinline__ void dil_unit(LAS unsigned char* lds, const bf16_t* Z, bf16_t* OA, float* LSE, const int sb, const int gh, const int u16) {
    int tid_ = threadIdx.x; asm volatile("" : "+v"(tid_));
    const int tid = tid_, lane = tid & 63, wid = __builtin_amdgcn_readfirstlane(tid >> 6), r32 = lane & 31, hi = lane >> 5;
    const int g = gh >> 3, lg = 2 * g, dil = 1 << lg;
    const int res = u16 & (dil - 1), qb = u16 >> lg;
    const int Msub = SEQ >> lg;
    const int tok0 = sb * SEQ;
    const int m0 = qb * 256, mq0 = m0 + wid * 32, mq = mq0 + r32;
    const size_t qtok = (size_t)tok0 + (size_t)mq * dil + res;
    bf16x8 qf[4];
#pragma unroll
    for (int s = 0; s < 4; ++s) qf[s] = *(const bf16x8*)(Z + zoff(qtok, C_QA + gh * 64 + s * 16 + hi * 8));
    f32x16 o[2];
#pragma unroll
    for (int r = 0; r < 16; ++r) { o[0][r] = 0.f; o[1][r] = 0.f; }
    float m = 0.f, l = 0.f; bool seen = false;
    f32x16 negm;
#pragma unroll
    for (int r = 0; r < 16; ++r) negm[r] = 0.f;
    LAS float* wsf = (LAS float*)(lds + AT_WSF + wid * 256);
    const int tt_lo = (m0 / 64 - 1) < 0 ? 0 : (m0 / 64 - 1);
    const int tt_hi = (m0 / 64 + 4) > (Msub / 64 - 1) ? (Msub / 64 - 1) : (m0 / 64 + 4);
    const int kk = tid >> 3, c = tid & 7;
    const bf16_t* ksrc = Z + zoff((size_t)tok0 + (size_t)kk * dil + res, C_KA + gh * 64 + c * 8);
    const size_t tstride = (size_t)64 * dil * 64, voffs = (size_t)((C_VA - C_KA) / 64) * ZBLK;
    const int ntile = tt_hi - tt_lo + 1;
    u32x4 rk0 = *(const u32x4*)(ksrc + tt_lo * tstride), rv0 = *(const u32x4*)(ksrc + tt_lo * tstride + voffs);
    u32x4 rk1 = *(const u32x4*)(ksrc + (tt_lo + 1) * tstride), rv1 = *(const u32x4*)(ksrc + (tt_lo + 1) * tstride + voffs);
    for (int j = 0; 2 * j < ntile; ++j) {
        const int ta = tt_lo + 2 * j, tb = ta + 1; const bool hasb = tb <= tt_hi;
        LAS unsigned char* kbuf = lds + AT_K + (j & 1) * AT_KB;
        LAS unsigned char* vbuf = lds + AT_V + (j & 1) * AT_VB;
        *(LAS u32x4*)(kbuf + kk * KSTR_A + c * 16) = rk0; *(LAS u32x4*)(vbuf + kk * VSTR + c * 16) = rv0;
        *(LAS u32x4*)(kbuf + (kk + 64) * KSTR_A + c * 16) = rk1; *(LAS u32x4*)(vbuf + (kk + 64) * VSTR + c * 16) = rv1;
        LDS_BARRIER();
        if (2 * (j + 1) < ntile) {
            const int t2 = ta + 2, t3 = (ta + 3 <= tt_hi) ? ta + 3 : ta + 2;
            rk0 = *(const u32x4*)(ksrc + t2 * tstride); rv0 = *(const u32x4*)(ksrc + t2 * tstride + voffs);
            rk1 = *(const u32x4*)(ksrc + t3 * tstride); rv1 = *(const u32x4*)(ksrc + t3 * tstride + voffs);
        }
        const bool act_a = (64 * ta + 63 >= mq0 - 64) && (64 * ta <= mq0 + 95);
        const bool act_b = hasb && (64 * tb + 63 >= mq0 - 64) && (64 * tb <= mq0 + 95);
        if (act_a) { bf16x8 kf[8]; attn_tile<4, true, false, false>(kf, kbuf, kbuf, KSTR_A, vbuf, qf, o, negm, m, l, seen, wsf, lane, 64 * ta - mq); }
        if (act_b) { bf16x8 kf[8]; attn_tile<4, true, false, false>(kf, kbuf + 64 * KSTR_A, kbuf, KSTR_A, vbuf + 64 * VSTR, qf, o, negm, m, l, seen, wsf, lane, 64 * tb - mq); }
    }
    LDS_BARRIER();
    const size_t qtok_w = (size_t)tok0 + (size_t)mq0 * dil + res;
    const float lt = attn_epilogue<false>(o, l, wsf, lds + AT_OST + wid * AT_OSTB, lane, OA + qtok_w * 1536 + gh * 64, (size_t)dil * 1536, nullptr, 0);
    if (hi == 0) LSE[qtok * 24 + gh] = m + __log2f(lt);
    LDS_BARRIER();
}

__device__ __forceinline__ int pk4_fp8(float a, float b, float c, float d) { int w = 0; w = __builtin_amdgcn_cvt_pk_fp8_f32(a, b, w, false); w = __builtin_amdgcn_cvt_pk_fp8_f32(c, d, w, true); return w; }
__device__ __forceinline__ void transpose_item8(const float* W, const float* gk, const float scale, int K, int N, unsigned char* WT, LAS float* scr, int item, int lane, int drow) {
    const int nblk = N / 32, kb = item / nblk, nb = item % nblk, k0 = 64 * kb, n0 = 32 * nb;
#pragma unroll 8
    for (int i = 0; i < 32; ++i) { const int kk = 2 * i + (lane >> 5); scr[kk * 33 + (lane & 31)] = W[(size_t)(k0 + kk) * N + n0 + (lane & 31)] * (gk[k0 + kk] * scale); }
    LDS_WAIT();
    const int c = lane & 7;
#pragma unroll
    for (int j = 0; j < 4; ++j) { const int n = (lane >> 3) + 8 * j; const LAS float* s = scr + (8 * c) * 33 + n;
        u32x2 o; o.x = (unsigned)pk4_fp8(s[0 * 33], s[1 * 33], s[2 * 33], s[3 * 33]); o.y = (unsigned)pk4_fp8(s[4 * 33], s[5 * 33], s[6 * 33], s[7 * 33]);
        *(u32x2*)(WT + (size_t)(drow + n) * K + k0 + 8 * c) = o; }
    LDS_WAIT();
}
__device__ __forceinline__ void transpose_item(const float* W, const float* gk, int K, int N, bf16_t* WT, LAS float* scr, int item, int lane, int drow = -1) {
    const int nblk = N / 32, kb = item / nblk, nb = item % nblk, k0 = 64 * kb, n0 = 32 * nb;
#pragma unroll 8
    for (int i = 0; i < 32; ++i) { const int kk = 2 * i + (lane >> 5); float w = W[(size_t)(k0 + kk) * N + n0 + (lane & 31)]; if (gk) w *= gk[k0 + kk]; scr[kk * 33 + (lane & 31)] = w; }
    LDS_WAIT();
    const int c = lane & 7;
#pragma unroll
    for (int j = 0; j < 4; ++j) { const int n = (lane >> 3) + 8 * j; const LAS float* s = scr + (8 * c) * 33 + n;
        u32x4 o; o.x = pk_bf16(s[0 * 33], s[1 * 33]); o.y = pk_bf16(s[2 * 33], s[3 * 33]); o.z = pk_bf16(s[4 * 33], s[5 * 33]); o.w = pk_bf16(s[6 * 33], s[7 * 33]);
        *(u32x4*)(WT + (size_t)((drow < 0 ? n0 : drow) + n) * K + k0 + 8 * c) = o; }
    LDS_WAIT();
}

__constant__ double kInvFreq[24] = {1.0, 0.19392274474868576, 0.03760603093086393, 0.007292664737217109, 0.001414213562373095, 0.0002742481756762073, 5.318295896944988e-05, 1.031338537721246e-05, 1.0, 0.5623413251903491, 0.31622776601683794, 0.1778279410038923, 0.1, 0.05623413251903491, 0.03162277660168379, 0.01778279410038923, 0.01, 0.005623413251903491, 0.0031622776601683794, 0.0017782794100389228, 0.001, 0.0005623413251903491, 0.00031622776601683794, 0.00017782794100389227};

__device__ __forceinline__ void sincos_d(double ang, float& c, float& s) {
    const double TWO_PI = 6.283185307179586476925286766559;
    const double k = rint(ang / TWO_PI);
    const double r = ang - k * TWO_PI;
    const double r2 = r * r;
    double ts = 1.0, tc = 1.0, ss = 1.0, cs = 1.0;
#pragma unroll 1
    for (int n = 1; n <= 16; ++n) {
        tc = -tc * r2 / (double)((2 * n - 1) * (2 * n));
        ts = -ts * r2 / (double)((2 * n) * (2 * n + 1));
        cs += tc; ss += ts;
    }
    c = (float)cs; s = (float)(ss * r);
}

template <class AP> __device__ __forceinline__ void prep_phase(AP a, LAS unsigned char* lds, const int g, const int G, const int bid) {
    int tid_ = threadIdx.x; asm volatile("" : "+v"(tid_));
    const int lane = tid_ & 63, wave = __builtin_amdgcn_readfirstlane(tid_ >> 6), gw = bid * 8 + wave, NGW = G * 8;
    unsigned char* ws = a->ws;
    float* ssq = (float*)(ws + WS_SSQ);
    if (g == 0) {
        LAS float* scr = (LAS float*)(lds + wave * 16384);
        constexpr int I_IN = (DM / 64) * (NIN / 32), I_Q = (256 / 64) * (768 / 32), I_KV = (128 / 64) * (1024 / 32), I_OA = (512 / 64) * (1024 / 32), I_O = (1024 / 64) * (1024 / 32);
        constexpr int NITEMS = I_IN + I_Q + I_KV + 2 * I_OA + I_O;
        for (int it = gw; it < NITEMS; it += NGW) {
            int r = it;
            if (r < I_IN) { const int nb = r % (NIN / 32), t = nb >> 3, w32 = (nb & 7) * 32;
                const int p8 = RUNS_F8.inv(t);
                if (p8 >= 0) transpose_item8(a->in[3], a->in[2], F8_SB, DM, NIN, ws + WS_WIN + 8 * MiB, scr, r, lane, p8 * 256 + w32);
                else transpose_item(a->in[3], a->in[2], DM, NIN, (bf16_t*)(ws + WS_WIN), scr, r, lane, RUNS_B16.inv(t) * 256 + w32);
                continue; } r -= I_IN;
            if (r < I_Q) { transpose_item(a->in[5], a->in[4], 256, 768, (bf16_t*)(ws + WS_WQ), scr, r, lane); continue; } r -= I_Q;
            if (r < I_KV) { transpose_item(a->in[7], a->in[6], 128, 1024, (bf16_t*)(ws + WS_WKV), scr, r, lane); continue; } r -= I_KV;
            if (r < I_OA) { transpose_item(a->in[8], nullptr, 512, 1024, (bf16_t*)(ws + WS_WOA), scr, r, lane); continue; } r -= I_OA;
            if (r < I_OA) { transpose_item(a->in[9], nullptr, 512, 1024, (bf16_t*)(ws + WS_WOB), scr, r, lane); continue; } r -= I_OA;
            transpose_item(a->in[10], nullptr, 1024, 1024, (bf16_t*)(ws + WS_WO), scr, r, lane);
        }
        { static_assert(RUNS_F8.inv(31) >= 0, "the padded tile is an fp8 tile");
          u32x4* pad = (u32x4*)(ws + WS_WIN + 8 * MiB + (size_t)(RUNS_F8.inv(31) * 256 + (NIN - 31 * 256)) * DM); const int n16 = (NINP - NIN) * DM / 16;
          unsigned zu = 0u; asm volatile("" : "+v"(zu));
          for (int i = gw * 64 + lane; i < n16; i += NGW * 64) pad[i] = (u32x4){zu, zu, zu, zu}; }
        { float* tabA = (float*)(ws + WS_TABA); float* tabB = (float*)(ws + WS_TABB);
          for (int i = gw * 64 + lane; i < SEQ * 24; i += NGW * 64) {
              const int pos = i / 24, f = i % 24; float cv, sv;
              const double inv = kInvFreq[f];
              sincos_d((double)pos * inv, cv, sv);
              if (f < 8) { tabA[pos * 16 + f] = cv; tabA[pos * 16 + 8 + f] = sv; }
              else { tabB[pos * 32 + (f - 8)] = cv; tabB[pos * 32 + 16 + (f - 8)] = sv; }
          } }
    }
    {
        const int s0 = g * GS;
        const float* xg = (s0 < NPSEQ) ? a->in[0] + (size_t)s0 * SEQ * DM : a->in[1] + (size_t)(s0 - NPSEQ) * SEQ * DM;
        bf16_t* HB = (bf16_t*)(ws + WS_HB); unsigned char* HB8 = ws + WS_HB8;
        float* ssqg = ssq + (size_t)g * TG * 4;
        float zf = 0.f; asm volatile("" : "+v"(zf));
        for (int row = gw; row < TG; row += 2 * NGW) {
            const int row1 = row + NGW; const bool has1 = row1 < TG; const int r1 = has1 ? row1 : row;
            const f32x4* xr0 = (const f32x4*)(xg + (size_t)row * DM) + lane; const f32x4* xr1 = (const f32x4*)(xg + (size_t)r1 * DM) + lane;
            f32x4 v0[4], v1[4]; float s0 = 0.f, s1 = 0.f;
#pragma unroll
            for (int j = 0; j < 4; ++j) { v0[j] = __builtin_nontemporal_load(xr0 + 64 * j); v1[j] = __builtin_nontemporal_load(xr1 + 64 * j); }
#pragma unroll
            for (int j = 0; j < 4; ++j) { s0 += (v0[j][0] * v0[j][0] + v0[j][1] * v0[j][1]) + (v0[j][2] * v0[j][2] + v0[j][3] * v0[j][3]); s1 += (v1[j][0] * v1[j][0] + v1[j][1] * v1[j][1]) + (v1[j][2] * v1[j][2] + v1[j][3] * v1[j][3]); }
            const float rstd0 = rsqrtf(wave_sum(s0) * (1.0f / DM) + EPS), rstd1 = rsqrtf(wave_sum(s1) * (1.0f / DM) + EPS);
            unsigned* o80 = (unsigned*)(HB8 + (size_t)row * DM) + lane; unsigned* o81 = (unsigned*)(HB8 + (size_t)r1 * DM) + lane;
            u32x2* b80 = (u32x2*)(HB + (size_t)row * DM) + lane; u32x2* b81 = (u32x2*)(HB + (size_t)r1 * DM) + lane;
            const float q0 = rstd0 * F8_SA, q1 = rstd1 * F8_SA;
#pragma unroll
            for (int j = 0; j < 4; ++j) { o80[64 * j] = (unsigned)pk4_fp8(v0[j][0] * q0, v0[j][1] * q0, v0[j][2] * q0, v0[j][3] * q0);
                u32x2 w; w.x = pk_bf16(v0[j][0] * rstd0, v0[j][1] * rstd0); w.y = pk_bf16(v0[j][2] * rstd0, v0[j][3] * rstd0); b80[64 * j] = w; }
            if (has1) {
#pragma unroll
                for (int j = 0; j < 4; ++j) { o81[64 * j] = (unsigned)pk4_fp8(v1[j][0] * q1, v1[j][1] * q1, v1[j][2] * q1, v1[j][3] * q1);
                    u32x2 w; w.x = pk_bf16(v1[j][0] * rstd1, v1[j][1] * rstd1); w.y = pk_bf16(v1[j][2] * rstd1, v1[j][3] * rstd1); b81[64 * j] = w; }
            }
            if (lane == 0) { *(f32x4*)(ssqg + (size_t)row * 4) = (f32x4){zf, zf, zf, zf}; if (has1) *(f32x4*)(ssqg + (size_t)row1 * 4) = (f32x4){zf, zf, zf, zf}; }
        }
    }
}

template <class AP> __device__ __forceinline__ void final_norm(AP a, const int g, const int G, const int bid) {
    int tid_ = threadIdx.x; asm volatile("" : "+v"(tid_));
    const int lane = tid_ & 63, wave = __builtin_amdgcn_readfirstlane(tid_ >> 6), gw = bid * 8 + wave, NGW = G * 8;
    const int s0 = g * GS;
    const float* xg = (s0 < NPSEQ) ? a->in[0] + (size_t)s0 * SEQ * DM : a->in[1] + (size_t)(s0 - NPSEQ) * SEQ * DM;
    const bf16_t* DL = (const bf16_t*)(a->ws + WS_UA);
    float* og = a->out + (size_t)g * TG * DM;
    const f32x4* gf = (const f32x4*)a->in[11] + lane;
    for (int row = gw; row < TG; row += 2 * NGW) {
        const int row1 = row + NGW; const bool has1 = row1 < TG; const int r1 = has1 ? row1 : row;
        const f32x4* xr0 = (const f32x4*)(xg + (size_t)row * DM) + lane; const f32x4* xr1 = (const f32x4*)(xg + (size_t)r1 * DM) + lane;
        const u32x2* dr0 = (const u32x2*)(DL + (size_t)row * DM) + lane; const u32x2* dr1 = (const u32x2*)(DL + (size_t)r1 * DM) + lane;
        f32x4 v0[4], v1[4]; u32x2 d0[4], d1[4]; float s0 = 0.f, s1 = 0.f;
#pragma unroll
        for (int j = 0; j < 4; ++j) { v0[j] = __builtin_nontemporal_load(xr0 + 64 * j); d0[j] = dr0[64 * j]; v1[j] = __builtin_nontemporal_load(xr1 + 64 * j); d1[j] = dr1[64 * j]; }
#pragma unroll
        for (int j = 0; j < 4; ++j) {
            v0[j] = v0[j] + (f32x4){bf_lo(d0[j].x), bf_hi(d0[j].x), bf_lo(d0[j].y), bf_hi(d0[j].y)}; v1[j] = v1[j] + (f32x4){bf_lo(d1[j].x), bf_hi(d1[j].x), bf_lo(d1[j].y), bf_hi(d1[j].y)};
            s0 += (v0[j][0] * v0[j][0] + v0[j][1] * v0[j][1]) + (v0[j][2] * v0[j][2] + v0[j][3] * v0[j][3]); s1 += (v1[j][0] * v1[j][0] + v1[j][1] * v1[j][1]) + (v1[j][2] * v1[j][2] + v1[j][3] * v1[j][3]); }
        const float rstd0 = rsqrtf(wave_sum(s0) * (1.0f / DM) + EPS), rstd1 = rsqrtf(wave_sum(s1) * (1.0f / DM) + EPS);
        f32x4* or0 = (f32x4*)(og + (size_t)row * DM) + lane; f32x4* or1 = (f32x4*)(og + (size_t)r1 * DM) + lane;
#pragma unroll
        for (int j = 0; j < 4; ++j) { const f32x4 gj = gf[64 * j]; __builtin_nontemporal_store(v0[j] * rstd0 * gj, or0 + 64 * j); if (has1) __builtin_nontemporal_store(v1[j] * rstd1 * gj, or1 + 64 * j); }
    }
}

__device__ __forceinline__ void combine_phase(unsigned char* ws, const int G, const int bid) {
    int tid_ = threadIdx.x; asm volatile("" : "+v"(tid_));
    const int lane = tid_ & 63, wave = __builtin_amdgcn_readfirstlane(tid_ >> 6), gw = bid * 8 + wave, NGW = G * 8;
    const bf16_t* Z = (const bf16_t*)(ws + WS_Z); const bf16_t* OA = (const bf16_t*)(ws + WS_OA); const float* LSE = (const float*)(ws + WS_LSE); bf16_t* UA = (bf16_t*)(ws + WS_UA);
    const int h = lane >> 3, c = lane & 7;
    for (int t0 = gw; t0 < TG; t0 += 2 * NGW) {
        u32x4 xa[2][3], ga[2]; float la[2][3]; bool has[2];
#pragma unroll
        for (int k = 0; k < 2; ++k) { const int t_ = t0 + k * NGW; has[k] = t_ < TG; const int t = has[k] ? t_ : t0;
            la[k][0] = LSE[(size_t)t * 24 + h]; la[k][1] = LSE[(size_t)t * 24 + 8 + h]; la[k][2] = LSE[(size_t)t * 24 + 16 + h];
            const bf16_t* ar = OA + (size_t)t * 1536 + h * 64 + c * 8;
            xa[k][0] = *(const u32x4*)(ar); xa[k][1] = *(const u32x4*)(ar + 512); xa[k][2] = *(const u32x4*)(ar + 1024);
            ga[k] = *(const u32x4*)(Z + zoff((size_t)t, C_GA + h * 64 + c * 8)); }
#pragma unroll
        for (int k = 0; k < 2; ++k) { if (!has[k]) continue; const int t = t0 + k * NGW;
            const float mx = fmaxf(la[k][0], fmaxf(la[k][1], la[k][2]));
            float e0 = __builtin_amdgcn_exp2f(la[k][0] - mx), e1 = __builtin_amdgcn_exp2f(la[k][1] - mx), e2 = __builtin_amdgcn_exp2f(la[k][2] - mx);
            const float inv = 1.0f / (e0 + e1 + e2); e0 *= inv; e1 *= inv; e2 *= inv;
            u32x4 ov;
#pragma unroll
            for (int w = 0; w < 4; ++w) {
                const float lo = (e0 * bf_lo(xa[k][0][w]) + e1 * bf_lo(xa[k][1][w]) + e2 * bf_lo(xa[k][2][w])) * bf_lo(ga[k][w]);
                const float hh = (e0 * bf_hi(xa[k][0][w]) + e1 * bf_hi(xa[k][1][w]) + e2 * bf_hi(xa[k][2][w])) * bf_hi(ga[k][w]);
                ov[w] = pk_bf16(lo, hh);
            }
            *(u32x4*)(UA + (size_t)t * 512 + h * 64 + c * 8) = ov; }
    }
}

#define XB_TMO      128
#define XB_XCNT(j)  (256  + 64 * (j))
#define XB_XSUB(j)  (1280 + 64 * (j))
#define XB_XGEN(j)  (2304 + 64 * (j))
#define XB_TOP      3328
#define XB_TOPGEN   3392
#define XCD_BAR_WORDS 3456
#define XB_SPIN_CAP (1u << 20)
__device__ __forceinline__ unsigned xb_ld(unsigned* p)              { return __hip_atomic_load(p, __ATOMIC_RELAXED, __HIP_MEMORY_SCOPE_AGENT); }
__device__ __forceinline__ unsigned xb_add(unsigned* p, unsigned v) { return __hip_atomic_fetch_add(p, v, __ATOMIC_RELAXED, __HIP_MEMORY_SCOPE_AGENT); }
__device__ __forceinline__ unsigned xb_xcc_id() { return (unsigned)__builtin_amdgcn_s_getreg((3 << 11) | 20) & 0xFu; }
#define XB_SPIN(cond, bar) do { unsigned _sp = 0; while (cond) { __builtin_amdgcn_s_sleep(1); \
    if ((++_sp & 255u) == 0u) { if (xb_ld(&(bar)[XB_TMO])) break; if (_sp > XB_SPIN_CAP) { atomicAdd(&(bar)[XB_TMO], 1u); break; } } } } while (0)
__device__ __forceinline__ void xcd_barrier_post(unsigned* bar) { if (threadIdx.x == 0) (void)xb_add(&bar[XB_XCNT(xb_xcc_id())], 1u); }
__device__ __forceinline__ void xcd_barrier_complete(unsigned* bar, unsigned x, unsigned& nloc, unsigned& nx) {
    const unsigned G = gridDim.x * gridDim.y * gridDim.z;
    unsigned sum, cnt, mine, sp = 0u;
    for (;;) {
        sum = 0u; cnt = 0u; mine = 0u;
#pragma unroll
        for (unsigned j = 0; j < 16; ++j) { const unsigned c = xb_ld(&bar[XB_XCNT(j)]); sum += c; cnt += (c > 0u) ? 1u : 0u; mine = (j == x) ? c : mine; }
        if (sum == G) break;
        __builtin_amdgcn_s_sleep(1);
        if ((++sp & 255u) == 0u) { if (xb_ld(&bar[XB_TMO])) break; if (sp > XB_SPIN_CAP) { atomicAdd(&bar[XB_TMO], 1u); break; } }
    }
    nloc = mine > 0u ? mine : 1u; nx = cnt > 0u ? cnt : 1u;
}
__device__ __forceinline__ void xcd_barrier(unsigned* bar, volatile LAS unsigned* st) {
    asm volatile("s_waitcnt vmcnt(0)" ::: "memory");
    __syncthreads();
    if (threadIdx.x == 0) {
        const unsigned x = xb_xcc_id();
        __builtin_amdgcn_s_waitcnt(0);
        unsigned nloc = st[0], nx = st[1];
        if (nloc == 0u) { xcd_barrier_complete(bar, x, nloc, nx); st[0] = nloc; st[1] = nx; }
        const unsigned old = xb_add(&bar[XB_XSUB(x)], 1u);
        const unsigned gen = old / nloc;
        if (old + 1u == (gen + 1u) * nloc) {
            __builtin_amdgcn_fence(__ATOMIC_RELEASE, "agent");
            asm volatile("s_waitcnt vmcnt(0)" ::: "memory");
            const unsigned og = xb_add(&bar[XB_TOP], 1u);
            const unsigned tg = og / nx;
            if (og + 1u == (tg + 1u) * nx) xb_add(&bar[XB_TOPGEN], 1u);
            else XB_SPIN(xb_ld(&bar[XB_TOPGEN]) == tg, bar);
            __builtin_amdgcn_fence(__ATOMIC_ACQUIRE, "agent");
            xb_add(&bar[XB_XGEN(x)], 1u);
            asm volatile("s_waitcnt vmcnt(0)" ::: "memory");
        } else {
            XB_SPIN(xb_ld(&bar[XB_XGEN(x)]) == gen, bar);
            __builtin_amdgcn_fence(__ATOMIC_ACQUIRE, "agent");
            asm volatile("s_waitcnt vmcnt(0)" ::: "memory");
        }
    }
    __syncthreads();
}

__global__ void __launch_bounds__(512, 2) mega_fwd(Args a) {
    extern __shared__ __attribute__((aligned(16))) unsigned char lds_raw[];
    LAS unsigned char* lds = (LAS unsigned char*)lds_raw;
    cg::grid_group grid = cg::this_grid();
    volatile LAS unsigned* bst = (volatile LAS unsigned*)(lds + 131072);
    if (threadIdx.x == 0) { bst[0] = 0u; bst[1] = 0u; }
    __syncthreads();
    xcd_barrier_post((unsigned*)(a.ws + WS_BAR));
    for (int ph = a.ph_lo; ph < a.ph_hi; ++ph) {
        if (ph == a.ph_lo + 1) grid.sync();
        else if (ph > a.ph_lo) { unsigned* bar = (unsigned*)(a.ws + WS_BAR); asm volatile("" : "+s"(bar)); xcd_barrier(bar, bst); }
        typedef const __attribute__((address_space(4))) Args* kargp_t;
        kargp_t ap = (kargp_t)__builtin_amdgcn_kernarg_segment_ptr();
        asm volatile("" : "+s"(ap));
        unsigned char* ws = ap->ws;
        int G = gridDim.x, bid = blockIdx.x;
        asm volatile("" : "+s"(G), "+s"(bid));
        const int vcu = (G % 8 == 0) ? (bid % 8) * (G / 8) + bid / 8 : bid;
        bf16_t* Z = (bf16_t*)(ws + WS_Z); bf16_t* HB = (bf16_t*)(ws + WS_HB); bf16_t* QB = (bf16_t*)(ws + WS_QB); bf16_t* KVB = (bf16_t*)(ws + WS_KVB);
        bf16_t* UA = (bf16_t*)(ws + WS_UA); bf16_t* UB = (bf16_t*)(ws + WS_UB); bf16_t* MG = (bf16_t*)(ws + WS_MG);
        float* LSE = (float*)(ws + WS_LSE); float* SSQ = (float*)(ws + WS_SSQ); bf16_t* OA = (bf16_t*)(ws + WS_OA);
        const float* tabA = (const float*)(ws + WS_TABA); const float* tabB = (const float*)(ws + WS_TABB);
        if (ph == NG * NPH) { final_norm(ap, NG - 1, G, bid); break; }
        const int g = ph / NPH, k = ph % NPH;
        float* ssqg = SSQ + (size_t)g * TG * 4;
        if (k == 0 && (PHM & 1)) {
            prep_phase(ap, lds, g, G, bid);
            if (g > 0) final_norm(ap, g - 1, G, bid);
            __syncthreads();
        } else if (k == 1 && (PHM & 2)) {
            { pg8::Gemm gm{HB, (const bf16_t*)(ws + WS_WIN), TG, RUNS_B16.count() * 256, DM, DM, 128}; pg8::StaticOrder S; S.init(TG, RUNS_B16.count() * 256, G, bid);
              EpiZ E{Z, ssqg, tabA, tabB, RUNS_B16, 1.0f};
              pg8::gemm_phase<EpiZ, pg8::StaticOrder, true, true, false>(lds, gm, S, E); }
            { pg8::Gemm gm{(const bf16_t*)(ws + WS_HB8), (const bf16_t*)(ws + WS_WIN + 8 * MiB), TG, RUNS_F8.count() * 256, DM / 2, DM / 2, 128}; pg8::StaticOrder S; S.init(TG, RUNS_F8.count() * 256, G, bid);
              EpiZ E{Z, ssqg, tabA, tabB, RUNS_F8, F8_DQ};
              pg8::gemm_phase<EpiZ, pg8::StaticOrder, true, true, true>(lds, gm, S, E); }
        } else if (k == 2 && (PHM & 4)) {
            { pg8::Gemm gm{Z + zoff(0, C_QL), (const bf16_t*)(ws + WS_WQ), TG, 768, 256, 64, ZBLK * 2};   pg8::StaticOrder S; S.init(TG, 768, G, bid);
              EpiQ E{QB, ssqg, tabB};
              pg8::gemm_phase<EpiQ, pg8::StaticOrder, true, true>(lds, gm, S, E); }
            { pg8::Gemm gm{Z + zoff(0, C_KVL), (const bf16_t*)(ws + WS_WKV), TG, 1024, 128, 64, ZBLK * 2}; pg8::StaticOrder S; S.init(TG, 1024, G, bid);
              EpiKV E{KVB, ssqg};
              pg8::gemm_phase<EpiKV, pg8::StaticOrder, true, true>(lds, gm, S, E); }
            __syncthreads();
            for (int u = vcu; u < GS * 24 * 16; u += G) { const int u16 = u & 15, gh = (u >> 4) % 24, sb = (u >> 4) / 24; dil_unit(lds, Z, OA, LSE, sb, gh, u16); }
        } else if (k == 3 && (PHM & 8)) {
            combine_phase(ws, G, bid);
            for (int u = vcu; u < GS * 8 * 16; u += G) { const int qb = u & 15, h = (u >> 4) & 7, sb = u >> 7; mla_unit(lds, QB, KVB, Z, UB, sb, h, qb); }
        } else if (k == 4 && (PHM & 16)) {
            pg8::StaticOrder S; S.init(TG, DM, G, bid);
            { pg8::Gemm gm{UA, (const bf16_t*)(ws + WS_WOA), TG, DM, 512, 512, 128}; EpiMerge<false> E{MG, Z, C_MGA};
              pg8::gemm_phase<EpiMerge<false>, pg8::StaticOrder, true, true>(lds, gm, S, E); }
            { pg8::Gemm gm{UB, (const bf16_t*)(ws + WS_WOB), TG, DM, 512, 512, 128}; EpiMerge<true> E{MG, Z, C_MGB};
              pg8::gemm_phase<EpiMerge<true>, pg8::StaticOrder, true, true>(lds, gm, S, E); }
        } else if (k == 5 && (PHM & 32)) {
            pg8::Gemm gm{MG, (const bf16_t*)(ws + WS_WO), TG, DM, DM, DM, 128}; pg8::StaticOrder S; S.init(TG, DM, G, bid);
            EpiDelta E{UA};
            pg8::gemm_phase<EpiDelta, pg8::StaticOrder, true, true>(lds, gm, S, E);
        }
    }
}

#ifndef PHM
#define PHM 63
#endif
#ifndef MK_COOP
#define MK_COOP 1
#endif
extern "C" void kernel_launch(void* const* d_in, const int* in_sizes, int n_in, void* d_out, int out_size, void* d_ws, size_t ws_size, hipStream_t stream) {
    static int grid = 0;
    if (grid == 0) {
        if (n_in != 12 || ws_size < WS_END || out_size != NSEQ * SEQ * DM) { fprintf(stderr, "kernel_launch: unexpected sizes (n_in %d, ws %zu, out %d)\n", n_in, ws_size, out_size); grid = -1; return; }
        int dev = 0, cus = 0, per_cu = 0;
        (void)hipGetDevice(&dev);
        (void)hipDeviceGetAttribute(&cus, hipDeviceAttributeMultiprocessorCount, dev);
        if (hipFuncSetAttribute((const void*)mega_fwd, hipFuncAttributeMaxDynamicSharedMemorySize, LDS_BYTES) != hipSuccess) { fprintf(stderr, "kernel_launch: hipFuncSetAttribute failed\n"); grid = -1; return; }
        if (hipOccupancyMaxActiveBlocksPerMultiprocessor(&per_cu, (const void*)mega_fwd, 512, LDS_BYTES) != hipSuccess || per_cu < 1) { fprintf(stderr, "kernel_launch: occupancy query failed (%d)\n", per_cu); per_cu = 1; }
        (void)hipGetLastError();
        grid = cus * per_cu;
        if (grid <= 0) grid = 256;
    }
    if (grid < 0) return;
    (void)hipMemsetAsync((unsigned char*)d_ws + WS_BAR, 0, XCD_BAR_WORDS * 4, stream);
    Args a{};
    for (int i = 0; i < 12; ++i) a.in[i] = (const float*)d_in[i];
    a.out = (float*)d_out; a.ws = (unsigned char*)d_ws;
#if MK_COOP
    a.ph_lo = 0; a.ph_hi = PH_TOTAL;
    void* args[] = {&a};
    hipError_t e = hipLaunchCooperativeKernel((const void*)mega_fwd, dim3(grid), dim3(512), args, LDS_BYTES, stream);
    if (e != hipSuccess) fprintf(stderr, "kernel_launch: cooperative launch failed: %s (grid %d)\n", hipGetErrorString(e), grid);
#else
    for (int ph = 0; ph < PH_TOTAL; ++ph) { a.ph_lo = ph; a.ph_hi = ph + 1; hipLaunchKernelGGL(mega_fwd, dim3(grid), dim3(512), LDS_BYTES, stream, a); }
#endif
}
```

```cpp
#include <hip/hip_runtime.h>
#include <hip/hip_cooperative_groups.h>
#include <cstdio>
#include <cstdint>
#include <cmath>
namespace cg = cooperative_groups;
#ifndef PHM
#define PHM 63
#endif
namespace pg8 {
#define PG8_LAS __attribute__((address_space(3)))
typedef unsigned short bf16_t;
typedef short bf16x8 __attribute__((ext_vector_type(8)));
typedef float f32x4 __attribute__((ext_vector_type(4)));
typedef unsigned u32x4 __attribute__((ext_vector_type(4)));
constexpr int BM = 256, BK = 64, HALF = 128, HTB = HALF * BK * 2  , STAGE_BYTES = 8 * HTB, NXCD = 8, WGM = 8;

__host__ __device__ __forceinline__ int lds_byte(int r, int c) { const int st = (r >> 4) * 2 + (c >> 5), rr = r & 15, cc = c & 31, ob = rr * 64 + cc * 2; return st * 1024 + (ob ^ (((ob >> 9) & 1) << 5)); }
__host__ __device__ __forceinline__ void stage_rc(int b, int& R, int& C) { const int st = b / 1024, sb = b % 1024, swz = sb ^ (((sb >> 9) & 1) << 5); R = (st >> 1) * 16 + swz / 64; C = (st & 1) * 32 + (swz % 64) / 2; }
__host__ __device__ __forceinline__ int perm32(int rho) { const int n = rho >> 4, i = rho & 15; return 8 * (i >> 2) + 4 * n + (i & 3); }

struct Unit { int pm, pn; };
struct Gemm { const bf16_t* A; const bf16_t* Bt; int M, N, K, lda; size_t kstepA; };

struct StaticOrder {
    int nM, nN, nwg, G, c;
    __host__ __device__ void init(int M, int N, int G_, int c_) { nM = M / BM; nN = N / BM; nwg = nM * nN; G = G_; c = c_; }
    __host__ __device__ bool next(int i, Unit& u) const {
        const long L = (long)i * G + c; if (L >= nwg) return false;
        int wgid = (int)L; { const int q = nwg / NXCD, r = nwg % NXCD, xcd = wgid % NXCD, off = wgid / NXCD; wgid = (xcd < r ? xcd * (q + 1) : r * (q + 1) + (xcd - r) * q) + off; }
        const int nig = WGM * nN, gid = wgid / nig, fm = gid * WGM, gsz = (nM - fm) < WGM ? (nM - fm) : WGM;
        u.pm = fm + ((wgid % nig) % gsz); u.pn = (wgid % nig) / gsz; return true;
    }
    __device__ __forceinline__ void a_ready(const Unit&) const {}
    __device__ __forceinline__ void done(const Unit&) const {}
};


typedef int i32x4_t __attribute__((ext_vector_type(4)));
typedef int i32x8_t __attribute__((ext_vector_type(8)));
__device__ __forceinline__ f32x4 mma_fp8(bf16x8 b0, bf16x8 b1, bf16x8 a0, bf16x8 a1, f32x4 c) {
    const i32x8_t B = __builtin_shufflevector(__builtin_bit_cast(i32x4_t, b0), __builtin_bit_cast(i32x4_t, b1), 0, 1, 2, 3, 4, 5, 6, 7);
    const i32x8_t A = __builtin_shufflevector(__builtin_bit_cast(i32x4_t, a0), __builtin_bit_cast(i32x4_t, a1), 0, 1, 2, 3, 4, 5, 6, 7);
    return __builtin_amdgcn_mfma_scale_f32_16x16x128_f8f6f4(B, A, c, 0, 0, 0, 0, 0, 0);
}
template <class Epi, class Sched, bool ALIGN_EPI = false, bool SP2 = false, bool FP8 = false>
__device__ __forceinline__ void gemm_phase(PG8_LAS unsigned char* lds, const Gemm g, const Sched& S, const Epi& E) {
    int tid_ = threadIdx.x; asm volatile("" : "+v"(tid_));
    const int tid = tid_, wid = __builtin_amdgcn_readfirstlane(tid >> 6), lane = tid & 63, wr = wid >> 2, wc = wid & 3, fr = lane & 15, fq = lane >> 4;
    const int K = g.K, nt = K / BK;
    unsigned voffA[2], voffB[2];
#pragma unroll
    for (int i = 0; i < 2; ++i) { int R, C; stage_rc(tid * 16 + i * 8192, R, C); const int Rb = Epi::PERM ? ((R & ~31) + perm32(R & 31)) : R;
        voffA[i] = (unsigned)(R * g.lda + C) * 2u; voffB[i] = (unsigned)(Rb * K + C) * 2u; }
    const size_t kstep = (size_t)(BK * 2), kstepA = g.kstepA;
    const size_t hstepA = (size_t)HALF * g.lda * 2, hstepB = (size_t)HALF * K * 2;
    const size_t tstepA = 2 * hstepA, tstepB = 2 * hstepB;
    const unsigned ldsw = (unsigned)wid * 1024u;
    const int aoff = lds_byte(wr * 64 + fr, fq * 8), boff = lds_byte(wc * 32 + fr, fq * 8);
#define PG8_SA(b, h) (((b) * 2 + (h)) * HTB)
#define PG8_SB(b, h) ((4 + (b) * 2 + (h)) * HTB)
#define PG8_STAGE(bufoff, gbase, voff) do { _Pragma("unroll") for (int _i = 0; _i < 2; ++_i) { unsigned vo_ = (voff)[_i]; asm volatile("" : "+v"(vo_));     \
        __builtin_amdgcn_global_load_lds((const unsigned*)((const char*)(gbase) + vo_), (PG8_LAS unsigned*)(lds + (bufoff) + ldsw + _i * 8192), 16, 0, 0); } } while (0)
#define PG8_LDA(dst, b, h) do { _Pragma("unroll") for (int m = 0; m < 4; ++m) _Pragma("unroll") for (int k = 0; k < 2; ++k) dst[m][k] = *(const PG8_LAS bf16x8*)(lds + PG8_SA(b, h) + aoff + m * 2048 + k * 1024); } while (0)
#define PG8_LDB(dst, b, h) do { _Pragma("unroll") for (int n = 0; n < 2; ++n) _Pragma("unroll") for (int k = 0; k < 2; ++k) dst[n][k] = *(const PG8_LAS bf16x8*)(lds + PG8_SB(b, h) + boff + n * 2048 + k * 1024); } while (0)
#define PG8_MMA(ai, bj, At, Bt) do { __builtin_amdgcn_s_setprio(1); _Pragma("unroll") for (int m = 0; m < 4; ++m) _Pragma("unroll") for (int n = 0; n < 2; ++n) { \
        if constexpr (FP8) acc[ai][bj][m][n] = mma_fp8(Bt[n][0], Bt[n][1], At[m][0], At[m][1], acc[ai][bj][m][n]); \
        else { _Pragma("unroll") for (int k = 0; k < 2; ++k) acc[ai][bj][m][n] = __builtin_amdgcn_mfma_f32_16x16x32_bf16(Bt[n][k], At[m][k], acc[ai][bj][m][n], 0, 0, 0); } } \
        __builtin_amdgcn_s_setprio(0); } while (0)
#define PG8_WAIT_V(n) asm volatile("s_waitcnt vmcnt(" #n ")" ::: "memory")
#define PG8_WAIT_L(n) asm volatile("s_waitcnt lgkmcnt(" #n ")" ::: "memory")
#define PG8_BAR __builtin_amdgcn_s_barrier()
#define PG8_SCHED __builtin_amdgcn_sched_barrier(0)
    Unit cur, nxt; int ui = 0;
    if (!S.next(0, cur)) return;
    f32x4 acc[2][2][4][2];
#pragma unroll
    for (int a = 0; a < 2; ++a)
#pragma unroll
        for (int b = 0; b < 2; ++b)
#pragma unroll
            for (int m = 0; m < 4; ++m)
#pragma unroll
                for (int n = 0; n < 2; ++n) acc[a][b][m][n] = (f32x4){0.f, 0.f, 0.f, 0.f};
    bf16x8 At[4][2], B0[2][2], B1[2][2];
    const char* cA = (const char*)g.A + (size_t)cur.pm * tstepA; const char* cB = (const char*)g.Bt + (size_t)cur.pn * tstepB;
    S.a_ready(cur);
    if constexpr (SP2) {
        PG8_STAGE(PG8_SB(0, 0), cB, voffB); PG8_STAGE(PG8_SB(0, 1), cB + hstepB, voffB); PG8_STAGE(PG8_SA(0, 0), cA, voffA); PG8_STAGE(PG8_SA(0, 1), cA + hstepA, voffA);
        if (wr == 1) PG8_BAR;
        PG8_WAIT_V(2); PG8_BAR;
        PG8_STAGE(PG8_SB(1, 0), cB + kstep, voffB); PG8_STAGE(PG8_SA(1, 0), cA + kstepA, voffA); PG8_STAGE(PG8_SB(1, 1), cB + hstepB + kstep, voffB);
        PG8_WAIT_V(6); PG8_BAR;
    } else {
        PG8_STAGE(PG8_SB(0, 0), cB, voffB); PG8_STAGE(PG8_SA(0, 0), cA, voffA); PG8_STAGE(PG8_SB(0, 1), cB + hstepB, voffB); PG8_STAGE(PG8_SA(0, 1), cA + hstepA, voffA);
        if (wr == 1) PG8_BAR;
        PG8_WAIT_V(4); PG8_BAR;
        PG8_STAGE(PG8_SB(1, 0), cB + kstep, voffB); PG8_STAGE(PG8_SA(1, 0), cA + kstepA, voffA); PG8_STAGE(PG8_SB(1, 1), cB + hstepB + kstep, voffB);
        PG8_WAIT_V(6); PG8_BAR;
    }
    for (;;) {
        const bool has_next = S.next(ui + 1, nxt);
        const char* nA = has_next ? (const char*)g.A + (size_t)nxt.pm * tstepA : cA; const char* nB = has_next ? (const char*)g.Bt + (size_t)nxt.pn * tstepB : cB;
#pragma unroll 1
        for (int t = 0; t < nt; t += 2) {
            const bool last = (t == nt - 2);
            const char* a1 = cA + (size_t)(t + 1) * kstepA;
            const char* a2 = last ? nA : cA + (size_t)(t + 2) * kstepA; const char* b2 = last ? nB : cB + (size_t)(t + 2) * kstep;
            const char* a3 = a2 + kstepA; const char* b3 = b2 + kstep;
            if (last && has_next) S.a_ready(nxt);
            if constexpr (SP2) {
            PG8_LDB(B0, 0, 0); PG8_LDB(B1, 0, 1); PG8_SCHED; PG8_LDA(At, 0, 0); PG8_STAGE(PG8_SA(1, 1), a1 + hstepA, voffA);
            PG8_WAIT_V(8); PG8_WAIT_L(0); PG8_BAR; PG8_MMA(0, 0, At, B0); PG8_MMA(0, 1, At, B1); PG8_BAR; PG8_SCHED;
            PG8_LDA(At, 0, 1); PG8_STAGE(PG8_SB(0, 0), b2, voffB); PG8_STAGE(PG8_SB(0, 1), b2 + hstepB, voffB); PG8_STAGE(PG8_SA(0, 0), a2, voffA);
            PG8_WAIT_V(8); PG8_WAIT_L(0); PG8_BAR; PG8_MMA(1, 0, At, B0); PG8_MMA(1, 1, At, B1); PG8_BAR; PG8_SCHED;
            PG8_LDB(B0, 1, 0); PG8_LDB(B1, 1, 1); PG8_SCHED; PG8_LDA(At, 1, 0); PG8_STAGE(PG8_SA(0, 1), a2 + hstepA, voffA);
            PG8_WAIT_V(8); PG8_WAIT_L(0); PG8_BAR; PG8_MMA(0, 0, At, B0); PG8_MMA(0, 1, At, B1); PG8_BAR; PG8_SCHED;
            PG8_LDA(At, 1, 1); PG8_STAGE(PG8_SB(1, 0), b3, voffB); PG8_STAGE(PG8_SB(1, 1), b3 + hstepB, voffB); PG8_STAGE(PG8_SA(1, 0), a3, voffA);
            PG8_WAIT_V(8); PG8_WAIT_L(0); PG8_BAR; PG8_MMA(1, 0, At, B0); PG8_MMA(1, 1, At, B1); PG8_BAR; PG8_SCHED;
            } else {
            PG8_LDB(B0, 0, 0); PG8_SCHED; PG8_LDA(At, 0, 0); PG8_STAGE(PG8_SA(1, 1), a1 + hstepA, voffA);
            PG8_WAIT_L(8); PG8_BAR; PG8_WAIT_L(0); PG8_MMA(0, 0, At, B0); PG8_BAR; PG8_SCHED;
            PG8_LDB(B1, 0, 1); PG8_STAGE(PG8_SB(0, 0), b2, voffB);
            PG8_BAR; PG8_WAIT_L(0); PG8_MMA(0, 1, At, B1); PG8_BAR;
            PG8_LDA(At, 0, 1); PG8_STAGE(PG8_SA(0, 0), a2, voffA);
            PG8_BAR; PG8_WAIT_L(0); PG8_MMA(1, 0, At, B0); PG8_BAR; PG8_SCHED;
            PG8_STAGE(PG8_SB(0, 1), b2 + hstepB, voffB);
            PG8_WAIT_V(6); PG8_BAR; PG8_MMA(1, 1, At, B1); PG8_BAR;
            PG8_LDB(B0, 1, 0); PG8_SCHED; PG8_LDA(At, 1, 0); PG8_STAGE(PG8_SA(0, 1), a2 + hstepA, voffA);
            PG8_WAIT_L(8); PG8_BAR; PG8_WAIT_L(0); PG8_MMA(0, 0, At, B0); PG8_BAR; PG8_SCHED;
            PG8_LDB(B1, 1, 1); PG8_STAGE(PG8_SB(1, 0), b3, voffB);
            PG8_BAR; PG8_WAIT_L(0); PG8_MMA(0, 1, At, B1); PG8_BAR;
            PG8_LDA(At, 1, 1); PG8_STAGE(PG8_SA(1, 0), a3, voffA);
            PG8_BAR; PG8_WAIT_L(0); PG8_MMA(1, 0, At, B0); PG8_BAR; PG8_SCHED;
            PG8_STAGE(PG8_SB(1, 1), b3 + hstepB, voffB);
            PG8_WAIT_V(6); PG8_BAR; PG8_MMA(1, 1, At, B1); PG8_BAR;
            }
        }
        if constexpr (ALIGN_EPI) { if (wr == 0) PG8_BAR; }
        if constexpr (!Epi::AFTER_DRAIN) { E(acc, cur, wr, wc, fr, fq); S.done(cur); }
        if (!has_next) break;
#pragma unroll
        for (int a = 0; a < 2; ++a)
#pragma unroll
            for (int b = 0; b < 2; ++b)
#pragma unroll
                for (int m = 0; m < 4; ++m)
#pragma unroll
                    for (int n = 0; n < 2; ++n) acc[a][b][m][n] = (f32x4){0.f, 0.f, 0.f, 0.f};
        cur = nxt; cA = nA; cB = nB; ++ui;
        if constexpr (ALIGN_EPI) { if (wr == 1) PG8_BAR; }
    }
    PG8_WAIT_V(0);
    if constexpr (!ALIGN_EPI) { if (wr == 0) PG8_BAR; }
    PG8_BAR;
    if constexpr (Epi::AFTER_DRAIN) { E.fused(acc, cur, wr, wc, fr, fq, lds, wid, lane); S.done(cur); }
#undef PG8_SA
#undef PG8_SB
#undef PG8_STAGE
#undef PG8_LDA
#undef PG8_LDB
#undef PG8_MMA
#undef PG8_WAIT_V
#undef PG8_WAIT_L
#undef PG8_BAR
#undef PG8_SCHED
}
}

using pg8::bf16_t; using pg8::bf16x8; using pg8::f32x4; using pg8::u32x4;
#define LAS __attribute__((address_space(3)))
typedef float f32x16 __attribute__((ext_vector_type(16)));
typedef float f32x2 __attribute__((ext_vector_type(2)));
typedef unsigned u32x2 __attribute__((ext_vector_type(2)));
typedef short s16x4 __attribute__((ext_vector_type(4)));
typedef __bf16 bf16x2_t __attribute__((ext_vector_type(2)));
#define MFMA32(a, b, c) __builtin_amdgcn_mfma_f32_32x32x16_bf16((a), (b), (c), 0, 0, 0)

__device__ __forceinline__ unsigned pk_bf16(float lo, float hi) { f32x2 v = {lo, hi}; bf16x2_t b = __builtin_convertvector(v, bf16x2_t); return __builtin_bit_cast(unsigned, b); }
__device__ __forceinline__ float bf_lo(unsigned w) { return __uint_as_float(w << 16); }
__device__ __forceinline__ float bf_hi(unsigned w) { return __uint_as_float(w & 0xffff0000u); }
__device__ __forceinline__ void st4bf(bf16_t* p, f32x4 v) { u32x2 w; w.x = pk_bf16(v[0], v[1]); w.y = pk_bf16(v[2], v[3]); *(u32x2*)p = w; }
__device__ __forceinline__ f32x4 ld4bf(const bf16_t* p) { const u32x2 w = *(const u32x2*)p; return (f32x4){bf_lo(w.x), bf_hi(w.x), bf_lo(w.y), bf_hi(w.y)}; }
__device__ __forceinline__ int crow(int r, int hi) { return (r & 3) + 8 * (r >> 2) + 4 * hi; }
__device__ __forceinline__ float x32_sum(float x) { auto rr = __builtin_amdgcn_permlane32_swap(__float_as_uint(x), __float_as_uint(x), false, false); return __uint_as_float(rr[0]) + __uint_as_float(rr[1]); }
__device__ __forceinline__ float x32_max(float x) { auto rr = __builtin_amdgcn_permlane32_swap(__float_as_uint(x), __float_as_uint(x), false, false); return fmaxf(__uint_as_float(rr[0]), __uint_as_float(rr[1])); }
__device__ __forceinline__ float x32_other(float x, bool lower_half) { auto rr = __builtin_amdgcn_permlane32_swap(__float_as_uint(x), __float_as_uint(x), false, false); return lower_half ? __uint_as_float(rr[1]) : __uint_as_float(rr[0]); }
__device__ __forceinline__ float x16_other(float x, bool even_row) { auto rr = __builtin_amdgcn_permlane16_swap(__float_as_uint(x), __float_as_uint(x), false, false); return even_row ? __uint_as_float(rr[1]) : __uint_as_float(rr[0]); }
__device__ __forceinline__ float x16_sum(float x) { auto rr = __builtin_amdgcn_permlane16_swap(__float_as_uint(x), __float_as_uint(x), false, false); return __uint_as_float(rr[0]) + __uint_as_float(rr[1]); }
template <int XM> __device__ __forceinline__ float swz_xor(float x) { return __int_as_float(__builtin_amdgcn_ds_swizzle(__float_as_int(x), (XM << 10) | 0x1f)); }
__device__ __forceinline__ float wave_sum(float v) {
    v += swz_xor<1>(v); v += swz_xor<2>(v); v += swz_xor<4>(v); v += swz_xor<8>(v); v += swz_xor<16>(v);
    return x32_sum(v);
}
#define LDS_WAIT() asm volatile("s_waitcnt lgkmcnt(0)" ::: "memory")

constexpr int DM = 1024, SEQ = 4096, NSEQ = 24, NPSEQ = 16;
constexpr int GS = 8, TG = GS * SEQ, NG = NSEQ / GS;
constexpr int NIN = 8096, NINP = 8192;
constexpr int C_QA = 0, C_KA = 1536, C_VA = 3072, C_GA = 4608, C_QL = 5120, C_KVL = 5376, C_KR = 5504, C_GB = 5536, C_MGA = 6048, C_MGB = 7072;
constexpr float EPS = 1e-6f;
constexpr size_t ZBLK = (size_t)GS * SEQ * 64;
__host__ __device__ __forceinline__ size_t zoff(size_t row, int col) { return (size_t)(col >> 6) * ZBLK + row * 64 + (size_t)(col & 63); }
struct TileRuns { int a0, a1, b0, b1;
    __host__ __device__ constexpr int count() const { return (a1 - a0) + (b1 - b0); }
    __host__ __device__ constexpr int map(int p) const { return p < (a1 - a0) ? a0 + p : b0 + (p - (a1 - a0)); }
    __host__ __device__ constexpr int inv(int t) const { return (t >= a0 && t < a1) ? t - a0 : ((t >= b0 && t < b1) ? (a1 - a0) + (t - b0) : -1); } };
#ifndef F8_VARIANT
#define F8_VARIANT 24
#endif
#if F8_VARIANT == 24
constexpr TileRuns RUNS_F8{6, 18, 20, 32}, RUNS_B16{0, 6, 18, 20};
#elif F8_VARIANT == 18
constexpr TileRuns RUNS_F8{12, 18, 20, 32}, RUNS_B16{0, 12, 18, 20};
#else
constexpr TileRuns RUNS_F8{20, 32, 32, 32}, RUNS_B16{0, 20, 20, 20};
#endif
static_assert(RUNS_F8.count() + RUNS_B16.count() == 32, "tile sets");
constexpr float F8_SA = 8.0f, F8_SB = 32.0f, F8_DQ = 1.0f / (F8_SA * F8_SB);
constexpr float LOG2E = 1.4426950408889634f;
constexpr float QA_SCALE = 0.125f * LOG2E;
constexpr float QB_SCALE = 0.10206207261596577f * LOG2E;
static_assert(NPSEQ % GS == 0 && NSEQ % GS == 0, "groups must not straddle the two inputs");

constexpr size_t MiB = 1u << 20;
constexpr size_t WS_Z = 0;
constexpr size_t WS_HB = 512 * MiB;
constexpr size_t WS_QB = 576 * MiB;
constexpr size_t WS_KVB = 624 * MiB;
constexpr size_t WS_UA = 688 * MiB;
constexpr size_t WS_UB = 720 * MiB;
constexpr size_t WS_MG = 752 * MiB;
constexpr size_t WS_LSE = 816 * MiB;
constexpr size_t WS_SSQ = 820 * MiB;
constexpr size_t WS_WIN = 824 * MiB;
constexpr size_t WS_WQ = 840 * MiB;
constexpr size_t WS_WKV = 841 * MiB;
constexpr size_t WS_WOA = 842 * MiB;
constexpr size_t WS_WOB = 843 * MiB;
constexpr size_t WS_WO = 844 * MiB;
constexpr size_t WS_TABA = 846 * MiB;
constexpr size_t WS_TABB = 847 * MiB;
constexpr size_t WS_OA = 848 * MiB;
constexpr size_t WS_BAR = 944 * MiB;
constexpr size_t WS_HB8 = 946 * MiB;
constexpr size_t WS_END = 978 * MiB;
static_assert((size_t)TG * NINP * 2 <= WS_HB && (size_t)TG * 24 * 4 <= 4 * MiB, "ws map");

constexpr int LDS_BYTES = 131072 + 1024;
constexpr int NPH = 6;
constexpr int PH_TOTAL = NG * NPH + 1;

struct Args { const float* in[12]; float* out; unsigned char* ws; int ph_lo, ph_hi; };

__device__ __forceinline__ float sigmoidf_(float x) { return __builtin_amdgcn_rcpf(1.0f + __builtin_amdgcn_exp2f(x * -1.4426950408889634f)); }

struct EpiZ {
    static constexpr bool PERM = true, AFTER_DRAIN = false;
    bf16_t* Z; float* ssq; const float* tabA; const float* tabB; TileRuns tr; float dq;
    __device__ __forceinline__ void operator()(const f32x4 (&acc)[2][2][4][2], const pg8::Unit& u, int wr, int wc, int fr, int fq) const {
        { int t_ = threadIdx.x; asm volatile("" : "+v"(t_)); fr = t_ & 15; fq = (t_ >> 4) & 3; }
        const int row0 = u.pm * 256 + wr * 64 + fr;
        const __amdgpu_buffer_rsrc_t zrs = __builtin_amdgcn_make_buffer_rsrc(Z, 0, 0x7fffffff, 0x00020000);
#pragma unroll
        for (int bj = 0; bj < 2; ++bj) {
            const int cg0 = tr.map(u.pn) * 256 + bj * 128 + wc * 32;
            if (cg0 >= NIN) continue;
            int kind;
            if (cg0 < C_KA) kind = ((cg0 & 63) == 0) ? 1 : 2;
            else if (cg0 < C_VA) kind = ((cg0 & 63) == 0) ? 3 : 0;
            else if (cg0 < C_GA) kind = 0;
            else if (cg0 < C_QL) kind = 4;
            else if (cg0 < C_KVL) kind = 7;
            else if (cg0 < C_KR) kind = 8;
            else if (cg0 < C_GB) kind = 6;
            else if (cg0 < C_MGA) kind = 4;
            else kind = 5;
#pragma unroll
            for (int ai = 0; ai < 2; ++ai)
#pragma unroll
                for (int m = 0; m < 4; ++m) {
                    const int row = row0 + ai * 128 + m * 16;
                    f32x4 v0 = acc[ai][bj][m][0] * dq, v1 = acc[ai][bj][m][1] * dq;
                    if (kind == 1 || kind == 3) {
                        const int pos = row & (SEQ - 1);
                        const f32x4 ca = *(const f32x4*)(tabA + pos * 16), cb = *(const f32x4*)(tabA + pos * 16 + 4), sa = *(const f32x4*)(tabA + pos * 16 + 8), sb = *(const f32x4*)(tabA + pos * 16 + 12);
                        f32x4 pa, pb;
#pragma unroll
                        for (int e = 0; e < 4; ++e) { pa[e] = x16_other(v0[e], (fq & 1) == 0); pb[e] = x16_other(v1[e], (fq & 1) == 0); }
                        if (fq == 0) { v0 = v0 * ca - pa * sa; v1 = v1 * cb - pb * sb; }
                        else if (fq == 1) { v0 = v0 * ca + pa * sa; v1 = v1 * cb + pb * sb; }
                        if (kind == 1) { v0 = v0 * QA_SCALE; v1 = v1 * QA_SCALE; }
                    } else if (kind == 2) { v0 = v0 * QA_SCALE; v1 = v1 * QA_SCALE; }
                    else if (kind == 4) {
#pragma unroll
                        for (int e = 0; e < 4; ++e) { v0[e] = v0[e] * sigmoidf_(v0[e]); v1[e] = v1[e] * sigmoidf_(v1[e]); }
                    } else if (kind == 5) {
#pragma unroll
                        for (int e = 0; e < 4; ++e) { v0[e] = sigmoidf_(v0[e]); v1[e] = sigmoidf_(v1[e]); }
                    } else if (kind == 6) {
                        const int pos = row & (SEQ - 1), i0 = 8 * (fq & 1);
                        const f32x4 ca = *(const f32x4*)(tabB + pos * 32 + i0), cb = *(const f32x4*)(tabB + pos * 32 + i0 + 4), sa = *(const f32x4*)(tabB + pos * 32 + 16 + i0), sb = *(const f32x4*)(tabB + pos * 32 + 16 + i0 + 4);
                        f32x4 pa, pb;
#pragma unroll
                        for (int e = 0; e < 4; ++e) { pa[e] = x32_other(v0[e], fq < 2); pb[e] = x32_other(v1[e], fq < 2); }
                        if (fq < 2) { v0 = v0 * ca - pa * sa; v1 = v1 * cb - pb * sb; }
                        else { v0 = v0 * ca + pa * sa; v1 = v1 * cb + pb * sb; }
                    } else if (kind == 7 || kind == 8) {
                        float s = 0.f;
#pragma unroll
                        for (int e = 0; e < 4; ++e) s += v0[e] * v0[e] + v1[e] * v1[e];
                        s = x16_sum(s); s = x32_sum(s);
                        if (fq == 0) atomicAdd(ssq + (size_t)row * 4 + (kind == 7 ? 0 : 1), s);
                    }
                    u32x4 w; w.x = pk_bf16(v0[0], v0[1]); w.y = pk_bf16(v0[2], v0[3]); w.z = pk_bf16(v1[0], v1[1]); w.w = pk_bf16(v1[2], v1[3]);
                    __builtin_amdgcn_raw_buffer_store_b128(w, zrs, (int)(zoff((size_t)row, cg0 + 8 * fq) * 2), 0, 16);
                }
        }
    }
};

__device__ __forceinline__ u32x4 pk8bf(const f32x4 a, const f32x4 b) { u32x4 w; w.x = pk_bf16(a[0], a[1]); w.y = pk_bf16(a[2], a[3]); w.z = pk_bf16(b[0], b[1]); w.w = pk_bf16(b[2], b[3]); return w; }
__device__ __forceinline__ f32x4 lo4(const u32x4 w) { return (f32x4){bf_lo(w.x), bf_hi(w.x), bf_lo(w.y), bf_hi(w.y)}; }
__device__ __forceinline__ f32x4 hi4(const u32x4 w) { return (f32x4){bf_lo(w.z), bf_hi(w.z), bf_lo(w.w), bf_hi(w.w)}; }

struct EpiQ {
    static constexpr bool PERM = true, AFTER_DRAIN = false;
    bf16_t* Q; const float* ssq; const float* tabB;
    __device__ __forceinline__ void operator()(const f32x4 (&acc)[2][2][4][2], const pg8::Unit& u, int wr, int wc, int fr, int fq) const {
        { int t_ = threadIdx.x; asm volatile("" : "+v"(t_)); fr = t_ & 15; fq = (t_ >> 4) & 3; }
        const int row0 = u.pm * 256 + wr * 64 + fr;
#pragma unroll
        for (int bj = 0; bj < 2; ++bj) {
            const int cg0 = u.pn * 256 + bj * 128 + wc * 32;
            const bool rope = (cg0 % 96) == 64;
#pragma unroll
            for (int ai = 0; ai < 2; ++ai)
#pragma unroll
                for (int m = 0; m < 4; ++m) {
                    const int row = row0 + ai * 128 + m * 16;
                    const float rs = rsqrtf(ssq[(size_t)row * 4 + 0] * (1.0f / 256.0f) + EPS) * QB_SCALE;
                    f32x4 v0 = acc[ai][bj][m][0] * rs, v1 = acc[ai][bj][m][1] * rs;
                    if (rope) {
                        const int pos = row & (SEQ - 1), i0 = 8 * (fq & 1);
                        const f32x4 ca = *(const f32x4*)(tabB + pos * 32 + i0), cb = *(const f32x4*)(tabB + pos * 32 + i0 + 4), sa = *(const f32x4*)(tabB + pos * 32 + 16 + i0), sb = *(const f32x4*)(tabB + pos * 32 + 16 + i0 + 4);
                        f32x4 pa, pb;
#pragma unroll
                        for (int e = 0; e < 4; ++e) { pa[e] = x32_other(v0[e], fq < 2); pb[e] = x32_other(v1[e], fq < 2); }
                        if (fq < 2) { v0 = v0 * ca - pa * sa; v1 = v1 * cb - pb * sb; }
                        else { v0 = v0 * ca + pa * sa; v1 = v1 * cb + pb * sb; }
                    }
                    *(u32x4*)(Q + (size_t)row * 768 + cg0 + 8 * fq) = pk8bf(v0, v1);
                }
        }
    }
};

struct EpiKV {
    static constexpr bool PERM = true, AFTER_DRAIN = false;
    bf16_t* KV; const float* ssq;
    __device__ __forceinline__ void operator()(const f32x4 (&acc)[2][2][4][2], const pg8::Unit& u, int wr, int wc, int fr, int fq) const {
        { int t_ = threadIdx.x; asm volatile("" : "+v"(t_)); fr = t_ & 15; fq = (t_ >> 4) & 3; }
        const int row0 = u.pm * 256 + wr * 64 + fr;
#pragma unroll
        for (int ai = 0; ai < 2; ++ai)
#pragma unroll
            for (int m = 0; m < 4; ++m) {
                const int row = row0 + ai * 128 + m * 16;
                const float rs = rsqrtf(ssq[(size_t)row * 4 + 1] * (1.0f / 128.0f) + EPS);
#pragma unroll
                for (int bj = 0; bj < 2; ++bj)
                    *(u32x4*)(KV + (size_t)row * 1024 + u.pn * 256 + bj * 128 + wc * 32 + 8 * fq) = pk8bf(acc[ai][bj][m][0] * rs, acc[ai][bj][m][1] * rs);
            }
    }
};

template <bool ADD> struct EpiMerge {
    static constexpr bool PERM = true, AFTER_DRAIN = false;
    bf16_t* MG; const bf16_t* Zg; int gcol;
    __device__ __forceinline__ void operator()(const f32x4 (&acc)[2][2][4][2], const pg8::Unit& u, int wr, int wc, int fr, int fq) const {
        { int t_ = threadIdx.x; asm volatile("" : "+v"(t_)); fr = t_ & 15; fq = (t_ >> 4) & 3; }
        const int row0 = u.pm * 256 + wr * 64 + fr, col0 = u.pn * 256 + wc * 32 + 8 * fq;
#pragma unroll
        for (int ai = 0; ai < 2; ++ai) {
            u32x4 gt[4][2], mo[4][2];
#pragma unroll
            for (int m = 0; m < 4; ++m)
#pragma unroll
                for (int bj = 0; bj < 2; ++bj) {
                    const size_t row = (size_t)(row0 + ai * 128 + m * 16); const int col = col0 + bj * 128;
                    gt[m][bj] = *(const u32x4*)(Zg + zoff(row, gcol + col));
                    if (ADD) mo[m][bj] = *(const u32x4*)(MG + row * 1024 + col);
                }
#pragma unroll
            for (int m = 0; m < 4; ++m)
#pragma unroll
                for (int bj = 0; bj < 2; ++bj) {
                    const size_t row = (size_t)(row0 + ai * 128 + m * 16); const int col = col0 + bj * 128;
                    f32x4 v0 = lo4(gt[m][bj]) * acc[ai][bj][m][0], v1 = hi4(gt[m][bj]) * acc[ai][bj][m][1];
                    if (ADD) { v0 = v0 + lo4(mo[m][bj]); v1 = v1 + hi4(mo[m][bj]); }
                    *(u32x4*)(MG + row * 1024 + col) = pk8bf(v0, v1);
                }
            asm volatile("" ::: "memory");
        }
    }
};

struct EpiDelta {
    static constexpr bool PERM = true, AFTER_DRAIN = false;
    bf16_t* Dl;
    __device__ __forceinline__ void operator()(const f32x4 (&acc)[2][2][4][2], const pg8::Unit& u, int wr, int wc, int fr, int fq) const {
        { int t_ = threadIdx.x; asm volatile("" : "+v"(t_)); fr = t_ & 15; fq = (t_ >> 4) & 3; }
        const int row0 = u.pm * 256 + wr * 64 + fr;
#pragma unroll
        for (int ai = 0; ai < 2; ++ai)
#pragma unroll
            for (int m = 0; m < 4; ++m) {
                const int row = row0 + ai * 128 + m * 16;
#pragma unroll
                for (int bj = 0; bj < 2; ++bj)
                    *(u32x4*)(Dl + (size_t)row * DM + u.pn * 256 + bj * 128 + wc * 32 + 8 * fq) = pk8bf(acc[ai][bj][m][0], acc[ai][bj][m][1]);
            }
    }
};

constexpr int KSTR_B = 208, KSTR_A = 144, VSTR = 192;
constexpr int AT_KB = 128 * KSTR_B, AT_VB = 128 * VSTR;
constexpr int AT_K = 0, AT_V = 2 * AT_KB, AT_WSF = AT_V + 2 * AT_VB, AT_END = AT_WSF + 8 * 256;
constexpr int AT_OST = 0, AT_OSTB = 32 * 144;
static_assert(AT_END <= 131072 && 8 * AT_OSTB <= 2 * AT_KB, "attention LDS");
constexpr float ATT_THR = 5.0f;
typedef short v4i16_t __attribute__((ext_vector_type(4)));
__device__ __forceinline__ float max3f(float a, float b, float c) { float r; asm("v_max3_f32 %0, %1, %2, %3" : "=v"(r) : "v"(a), "v"(b), "v"(c)); return r; }
__device__ __forceinline__ s16x4 vtr(const LAS unsigned char* p) { return __builtin_bit_cast(s16x4, __builtin_amdgcn_ds_read_tr16_b64_v4i16((LAS v4i16_t*)p)); }

template <int NS, int S0 = 0, int S1 = NS>
__device__ __forceinline__ void load_kfrags(bf16x8 (&kf)[2 * NS], const LAS unsigned char* kb, const int kstr, const int lane) {
    const LAS unsigned char* kp = kb + (lane & 31) * kstr + (lane >> 5) * 16;
#pragma unroll
    for (int s = S0; s < S1; ++s) { kf[2 * s] = *(const LAS bf16x8*)(kp + s * 32); kf[2 * s + 1] = *(const LAS bf16x8*)(kp + 32 * kstr + s * 32); }
}

template <int NS, bool MASK, bool PRE, bool HALF_IN>
__device__ __forceinline__ void attn_tile(bf16x8 (&kf)[2 * NS], const LAS unsigned char* kb_cur, const LAS unsigned char* kb_next, const int kstr, const LAS unsigned char* vb, const bf16x8 (&qf)[NS],
                                          f32x16 (&o)[2], f32x16& negm, float& m, float& l, bool& seen, LAS float* wsf, const int lane, const int dm  ) {
    const int r32 = lane & 31, hi = lane >> 5;
    if (HALF_IN) load_kfrags<NS, NS / 2, NS>(kf, kb_cur, kstr, lane); else load_kfrags<NS, 0, NS>(kf, kb_cur, kstr, lane);
    f32x16 p0 = MFMA32(kf[0], qf[0], negm), p1 = MFMA32(kf[1], qf[0], negm);
#pragma unroll
    for (int s = 1; s < NS; ++s) { p0 = MFMA32(kf[2 * s], qf[s], p0); p1 = MFMA32(kf[2 * s + 1], qf[s], p1); }
    bf16x8 vf[8];
    const int q4 = (lane & 15) >> 2, p4 = lane & 3, b16 = (lane >> 4) & 1;
    const LAS unsigned char* vp = vb + (4 * hi + q4) * VSTR + b16 * 32 + p4 * 8;
#pragma unroll
    for (int blk = 0; blk < 2; ++blk)
#pragma unroll
        for (int s = 0; s < 2; ++s) {
            const LAS unsigned char* a = vp + (32 * blk + 16 * s) * VSTR;
            const s16x4 lo = vtr(a), h4 = vtr(a + 8 * VSTR);
            vf[blk * 2 + s] = (bf16x8){lo[0], lo[1], lo[2], lo[3], h4[0], h4[1], h4[2], h4[3]};
        }
    if (PRE) load_kfrags<NS, 0, NS / 2>(kf, kb_next, kstr, lane);
    if (MASK) {
#pragma unroll
        for (int r = 0; r < 16; ++r) { const int d0 = dm + crow(r, hi), d1 = d0 + 32;
            if (d0 < -64 || d0 > 64) p0[r] = -INFINITY;
            if (d1 < -64 || d1 > 64) p1[r] = -INFINITY; }
    }
    asm volatile("s_nop 15\n\ts_nop 7" : "+v"(p0), "+v"(p1));
    float rm;
    { float ma = max3f(p0[0], p0[1], p1[0]), mb = max3f(p0[2], p0[3], p1[1]); ma = max3f(ma, p1[2], p1[3]);
#pragma unroll
      for (int r = 4; r < 16; r += 4) { ma = max3f(ma, p0[r], p0[r + 1]); mb = max3f(mb, p0[r + 2], p0[r + 3]); ma = max3f(ma, p1[r], p1[r + 1]); mb = max3f(mb, p1[r + 2], p1[r + 3]); }
      rm = max3f(ma, mb, mb); }
    rm = x32_max(rm);
    const bool valid = rm > -INFINITY;
    const bool upd = (rm > ATT_THR) || (!seen && valid);
    if (__any(upd)) {
        const float d = upd ? rm : 0.f;
        const float alpha = (seen && upd) ? __builtin_amdgcn_exp2f(-d) : 1.f;
        m += d; l *= alpha;
#pragma unroll
        for (int r = 0; r < 16; ++r) { p0[r] -= d; p1[r] -= d; negm[r] = -m; }
        if (hi == 0) wsf[r32] = alpha;
#pragma unroll
        for (int g4 = 0; g4 < 4; ++g4) { const f32x4 a4 = *(const LAS f32x4*)(wsf + 8 * g4 + 4 * hi);
#pragma unroll
            for (int j = 0; j < 4; ++j) { o[0][4 * g4 + j] *= a4[j]; o[1][4 * g4 + j] *= a4[j]; } }
    }
    seen = seen || valid;
    float sum = 0.f;
#pragma unroll
    for (int r = 0; r < 16; ++r) { p0[r] = __builtin_amdgcn_exp2f(p0[r]); p1[r] = __builtin_amdgcn_exp2f(p1[r]); sum += p0[r] + p1[r]; }
    l += sum;
    bf16x8 pa[2][2];
#pragma unroll
    for (int s = 0; s < 2; ++s) {
        u32x4 w0, w1;
#pragma unroll
        for (int j = 0; j < 4; ++j) { w0[j] = pk_bf16(p0[8 * s + 2 * j], p0[8 * s + 2 * j + 1]); w1[j] = pk_bf16(p1[8 * s + 2 * j], p1[8 * s + 2 * j + 1]); }
        pa[0][s] = __builtin_bit_cast(bf16x8, w0); pa[1][s] = __builtin_bit_cast(bf16x8, w1);
    }
#pragma unroll
    for (int blk = 0; blk < 2; ++blk)
#pragma unroll
        for (int s = 0; s < 2; ++s) {
            const LAS unsigned char* a = vp + (32 * blk + 16 * s) * VSTR + 64;
            const s16x4 lo = vtr(a), h4 = vtr(a + 8 * VSTR);
            vf[4 + blk * 2 + s] = (bf16x8){lo[0], lo[1], lo[2], lo[3], h4[0], h4[1], h4[2], h4[3]};
        }
#pragma unroll
    for (int dd = 0; dd < 2; ++dd)
#pragma unroll
        for (int blk = 0; blk < 2; ++blk)
#pragma unroll
            for (int s = 0; s < 2; ++s) o[dd] = MFMA32(pa[blk][s], vf[dd * 4 + blk * 2 + s], o[dd]);
}

template <bool GATE>
__device__ __forceinline__ float attn_epilogue(const f32x16 (&o)[2], const float l, LAS float* wsf, LAS unsigned char* ost, const int lane,
                                               bf16_t* obase, const size_t ostride, const bf16_t* gbase, const size_t gstride) {
    const int r32 = lane & 31, hi = lane >> 5;
    const float lt = x32_sum(l);
    const float inv = 1.0f / lt;
    if (hi == 0) wsf[r32] = inv;
#pragma unroll
    for (int g4 = 0; g4 < 4; ++g4) { const f32x4 iv = *(const LAS f32x4*)(wsf + 8 * g4 + 4 * hi);
#pragma unroll
        for (int j = 0; j < 4; ++j) { const int row = 8 * g4 + 4 * hi + j;
#pragma unroll
            for (int dd = 0; dd < 2; ++dd) { const float v = o[dd][4 * g4 + j] * iv[j];
                *(LAS unsigned short*)(ost + row * 144 + (dd * 32 + r32) * 2) = (unsigned short)(pk_bf16(v, v) & 0xffffu); } } }
    LDS_WAIT();
#pragma unroll
    for (int i = 0; i < 4; ++i) { const int row = i * 8 + (lane >> 3), ch = lane & 7;
        u32x4 v = *(const LAS u32x4*)(ost + row * 144 + ch * 16);
        if (GATE) { const u32x4 gt = *(const u32x4*)(gbase + (size_t)row * gstride);
#pragma unroll
            for (int w = 0; w < 4; ++w) v[w] = pk_bf16(bf_lo(v[w]) * bf_lo(gt[w]), bf_hi(v[w]) * bf_hi(gt[w])); }
        *(u32x4*)(obase + (size_t)row * ostride + ch * 8) = v; }
    LDS_WAIT();
    return lt;
}

__device__ __forceinline__ void mla_unit(LAS unsigned char* lds, const bf16_t* QB, const bf16_t* KVB, const bf16_t* Z, bf16_t* UB, const int sb, const int h, const int qb) {
    int tid_ = threadIdx.x; asm volatile("" : "+v"(tid_));
    const int tid = tid_, lane = tid & 63, wid = __builtin_amdgcn_readfirstlane(tid >> 6), r32 = lane & 31, hi = lane >> 5;
    const int tok0 = sb * SEQ;
    const int qrow = tok0 + qb * 256 + wid * 32 + r32;
    bf16x8 qf[6];
#pragma unroll
    for (int s = 0; s < 6; ++s) qf[s] = *(const bf16x8*)(QB + (size_t)qrow * 768 + h * 96 + s * 16 + hi * 8);
    f32x16 o[2];
#pragma unroll
    for (int r = 0; r < 16; ++r) { o[0][r] = 0.f; o[1][r] = 0.f; }
    float m = 0.f, l = 0.f; bool seen = false;
    f32x16 negm;
#pragma unroll
    for (int r = 0; r < 16; ++r) negm[r] = 0.f;
    bf16x8 kf[12];
    LAS float* wsf = (LAS float*)(lds + AT_WSF + wid * 256);
    const int kk = tid >> 3, c = tid & 7, kk2 = tid >> 2, c2 = tid & 3;
    const bf16_t* kvsrc = KVB + (size_t)(tok0 + kk) * 1024 + h * 128 + c * 8;
    const bf16_t* pesrc = Z + zoff((size_t)(tok0 + kk2), C_KR + c2 * 8);
    u32x4 rk0 = *(const u32x4*)kvsrc, rv0 = *(const u32x4*)(kvsrc + 64), rk1 = *(const u32x4*)(kvsrc + 64 * 1024), rv1 = *(const u32x4*)(kvsrc + 64 * 1024 + 64), rp = *(const u32x4*)pesrc;
    constexpr int NST = SEQ / 128;
    for (int st = 0; st < NST; ++st) {
        LAS unsigned char* kbuf = lds + AT_K + (st & 1) * AT_KB;
        LAS unsigned char* vbuf = lds + AT_V + (st & 1) * AT_VB;
        *(LAS u32x4*)(kbuf + kk * KSTR_B + c * 16) = rk0; *(LAS u32x4*)(kbuf + (kk + 64) * KSTR_B + c * 16) = rk1;
        *(LAS u32x4*)(vbuf + kk * VSTR + c * 16) = rv0; *(LAS u32x4*)(vbuf + (kk + 64) * VSTR + c * 16) = rv1;
        *(LAS u32x4*)(kbuf + kk2 * KSTR_B + 128 + c2 * 16) = rp;
        __syncthreads();
        if (st + 1 < NST) {
            const size_t adv = (size_t)(st + 1) * 128;
            rk0 = *(const u32x4*)(kvsrc + adv * 1024); rv0 = *(const u32x4*)(kvsrc + adv * 1024 + 64);
            rk1 = *(const u32x4*)(kvsrc + (adv + 64) * 1024); rv1 = *(const u32x4*)(kvsrc + (adv + 64) * 1024 + 64);
            rp = *(const u32x4*)(pesrc + adv * 64);
        }
        attn_tile<6, false, true, false>(kf, kbuf, kbuf + 64 * KSTR_B, KSTR_B, vbuf, qf, o, negm, m, l, seen, wsf, lane, 0);
        attn_tile<6, false, false, true>(kf, kbuf + 64 * KSTR_B, kbuf, KSTR_B, vbuf + 64 * VSTR, qf, o, negm, m, l, seen, wsf, lane, 0);
    }
    __syncthreads();
    const size_t orow = (size_t)(tok0 + qb * 256 + wid * 32);
    attn_epilogue<true>(o, l, wsf, lds + AT_OST + wid * AT_OSTB, lane, UB + orow * 512 + h * 64, 512, Z + zoff(orow, C_GB + h * 64 + (lane & 7) * 8), 64);
    __syncthreads();
}

__device__ __forceinline__ void dil_unit(LAS unsigned char* lds, const bf16_t* Z, bf16_t* OA, float* LSE, const int sb, const int gh, const int u16) {
    int tid_ = threadIdx.x; asm volatile("" : "+v"(tid_));
    const int tid = tid_, lane = tid & 63, wid = __builtin_amdgcn_readfirstlane(tid >> 6), r32 = lane & 31, hi = lane >> 5;
    const int g = gh >> 3, lg = 2 * g, dil = 1 << lg;
    const int res = u16 & (dil - 1), qb = u16 >> lg;
    const int Msub = SEQ >> lg;
    const int tok0 = sb * SEQ;
    const int m0 = qb * 256, mq0 = m0 + wid * 32, mq = mq0 + r32;
    const size_t qtok = (size_t)tok0 + (size_t)mq * dil + res;
    bf16x8 qf[4];
#pragma unroll
    for (int s = 0; s < 4; ++s) qf[s] = *(const bf16x8*)(Z + zoff(qtok, C_QA + gh * 64 + s * 16 + hi * 8));
    f32x16 o[2];
#pragma unroll
    for (int r = 0; r < 16; ++r) { o[0][r] = 0.f; o[1][r] = 0.f; }
    float m = 0.f, l = 0.f; bool seen = false;
    f32x16 negm;
#pragma unroll
    for (int r = 0; r < 16; ++r) negm[r] = 0.f;
    LAS float* wsf = (LAS float*)(lds + AT_WSF + wid * 256);
    const int tt_lo = (m0 / 64 - 1) < 0 ? 0 : (m0 / 64 - 1);
    const int tt_hi = (m0 / 64 + 4) > (Msub / 64 - 1) ? (Msub / 64 - 1) : (m0 / 64 + 4);
    const int kk = tid >> 3, c = tid & 7;
    const bf16_t* ksrc = Z + zoff((size_t)tok0 + (size_t)kk * dil + res, C_KA + gh * 64 + c * 8);
    const size_t tstride = (size_t)64 * dil * 64, voffs = (size_t)((C_VA - C_KA) / 64) * ZBLK;
    const int ntile = tt_hi - tt_lo + 1;
    u32x4 rk0 = *(const u32x4*)(ksrc + tt_lo * tstride), rv0 = *(const u32x4*)(ksrc + tt_lo * tstride + voffs);
    u32x4 rk1 = *(const u32x4*)(ksrc + (tt_lo + 1) * tstride), rv1 = *(const u32x4*)(ksrc + (tt_lo + 1) * tstride + voffs);
    for (int j = 0; 2 * j < ntile; ++j) {
        const int ta = tt_lo + 2 * j, tb = ta + 1; const bool hasb = tb <= tt_hi;
        LAS unsigned char* kbuf = lds + AT_K + (j & 1) * AT_KB;
        LAS unsigned char* vbuf = lds + AT_V + (j & 1) * AT_VB;
        *(LAS u32x4*)(kbuf + kk * KSTR_A + c * 16) = rk0; *(LAS u32x4*)(vbuf + kk * VSTR + c * 16) = rv0;
        *(LAS u32x4*)(kbuf + (kk + 64) * KSTR_A + c * 16) = rk1; *(LAS u32x4*)(vbuf + (kk + 64) * VSTR + c * 16) = rv1;
        __syncthreads();
        if (2 * (j + 1) < ntile) {
            const int t2 = ta + 2, t3 = (ta + 3 <= tt_hi) ? ta + 3 : ta + 2;
            rk0 = *(const u32x4*)(ksrc + t2 * tstride); rv0 = *(const u32x4*)(ksrc + t2 * tstride + voffs);
            rk1 = *(const u32x4*)(ksrc + t3 * tstride); rv1 = *(const u32x4*)(ksrc + t3 * tstride + voffs);
        }
        const bool act_a = (64 * ta + 63 >= mq0 - 64) && (64 * ta <= mq0 + 95);
        const bool act_b = hasb && (64 * tb + 63 >= mq0 - 64) && (64 * tb <= mq0 + 95);
        if (act_a) { bf16x8 kf[8]; attn_tile<4, true, false, false>(kf, kbuf, kbuf, KSTR_A, vbuf, qf, o, negm, m, l, seen, wsf, lane, 64 * ta - mq); }
        if (act_b) { bf16x8 kf[8]; attn_tile<4, true, false, false>(kf, kbuf + 64 * KSTR_A, kbuf, KSTR_A, vbuf + 64 * VSTR, qf, o, negm, m, l, seen, wsf, lane, 64 * tb - mq); }
    }
    __syncthreads();
    const size_t qtok_w = (size_t)tok0 + (size_t)mq0 * dil + res;
    const float lt = attn_epilogue<false>(o, l, wsf, lds + AT_OST + wid * AT_OSTB, lane, OA + qtok_w * 1536 + gh * 64, (size_t)dil * 1536, nullptr, 0);
    if (hi == 0) LSE[qtok * 24 + gh] = m + __log2f(lt);
    __syncthreads();
}

__device__ __forceinline__ int pk4_fp8(float a, float b, float c, float d) { int w = 0; w = __builtin_amdgcn_cvt_pk_fp8_f32(a, b, w, false); w = __builtin_amdgcn_cvt_pk_fp8_f32(c, d, w, true); return w; }
__device__ __forceinline__ void transpose_item8(const float* W, const float* gk, const float scale, int K, int N, unsigned char* WT, LAS float* scr, int item, int lane, int drow) {
    const int nblk = N / 32, kb = item / nblk, nb = item % nblk, k0 = 64 * kb, n0 = 32 * nb;
#pragma unroll 8
    for (int i = 0; i < 32; ++i) { const int kk = 2 * i + (lane >> 5); scr[kk * 33 + (lane & 31)] = W[(size_t)(k0 + kk) * N + n0 + (lane & 31)] * (gk[k0 + kk] * scale); }
    LDS_WAIT();
    const int c = lane & 7;
#pragma unroll
    for (int j = 0; j < 4; ++j) { const int n = (lane >> 3) + 8 * j; const LAS float* s = scr + (8 * c) * 33 + n;
        u32x2 o; o.x = (unsigned)pk4_fp8(s[0 * 33], s[1 * 33], s[2 * 33], s[3 * 33]); o.y = (unsigned)pk4_fp8(s[4 * 33], s[5 * 33], s[6 * 33], s[7 * 33]);
        *(u32x2*)(WT + (size_t)(drow + n) * K + k0 + 8 * c) = o; }
    LDS_WAIT();
}
__device__ __forceinline__ void transpose_item(const float* W, const float* gk, int K, int N, bf16_t* WT, LAS float* scr, int item, int lane, int drow = -1) {
    const int nblk = N / 32, kb = item / nblk, nb = item % nblk, k0 = 64 * kb, n0 = 32 * nb;
#pragma unroll 8
    for (int i = 0; i < 32; ++i) { const int kk = 2 * i + (lane >> 5); float w = W[(size_t)(k0 + kk) * N + n0 + (lane & 31)]; if (gk) w *= gk[k0 + kk]; scr[kk * 33 + (lane & 31)] = w; }
    LDS_WAIT();
    const int c = lane & 7;
#pragma unroll
    for (int j = 0; j < 4; ++j) { const int n = (lane >> 3) + 8 * j; const LAS float* s = scr + (8 * c) * 33 + n;
        u32x4 o; o.x = pk_bf16(s[0 * 33], s[1 * 33]); o.y = pk_bf16(s[2 * 33], s[3 * 33]); o.z = pk_bf16(s[4 * 33], s[5 * 33]); o.w = pk_bf16(s[6 * 33], s[7 * 33]);
        *(u32x4*)(WT + (size_t)((drow < 0 ? n0 : drow) + n) * K + k0 + 8 * c) = o; }
    LDS_WAIT();
}

__constant__ double kInvFreq[24] = {1.0, 0.19392274474868576, 0.03760603093086393, 0.007292664737217109, 0.001414213562373095, 0.0002742481756762073, 5.318295896944988e-05, 1.031338537721246e-05, 1.0, 0.5623413251903491, 0.31622776601683794, 0.1778279410038923, 0.1, 0.05623413251903491, 0.03162277660168379, 0.01778279410038923, 0.01, 0.005623413251903491, 0.0031622776601683794, 0.0017782794100389228, 0.001, 0.0005623413251903491, 0.00031622776601683794, 0.00017782794100389227};

__device__ __forceinline__ void sincos_d(double ang, float& c, float& s) {
    const double TWO_PI = 6.283185307179586476925286766559;
    const double k = rint(ang / TWO_PI);
    const double r = ang - k * TWO_PI;
    const double r2 = r * r;
    double ts = 1.0, tc = 1.0, ss = 1.0, cs = 1.0;
#pragma unroll 1
    for (int n = 1; n <= 16; ++n) {
        tc = -tc * r2 / (double)((2 * n - 1) * (2 * n));
        ts = -ts * r2 / (double)((2 * n) * (2 * n + 1));
        cs += tc; ss += ts;
    }
    c = (float)cs; s = (float)(ss * r);
}

template <class AP> __device__ __forceinline__ void prep_phase(AP a, LAS unsigned char* lds, const int g, const int G, const int bid) {
    int tid_ = threadIdx.x; asm volatile("" : "+v"(tid_));
    const int lane = tid_ & 63, wave = __builtin_amdgcn_readfirstlane(tid_ >> 6), gw = bid * 8 + wave, NGW = G * 8;
    unsigned char* ws = a->ws;
    float* ssq = (float*)(ws + WS_SSQ);
    if (g == 0) {
        LAS float* scr = (LAS float*)(lds + wave * 16384);
        constexpr int I_IN = (DM / 64) * (NIN / 32), I_Q = (256 / 64) * (768 / 32), I_KV = (128 / 64) * (1024 / 32), I_OA = (512 / 64) * (1024 / 32), I_O = (1024 / 64) * (1024 / 32);
        constexpr int NITEMS = I_IN + I_Q + I_KV + 2 * I_OA + I_O;
        for (int it = gw; it < NITEMS; it += NGW) {
            int r = it;
            if (r < I_IN) { const int nb = r % (NIN / 32), t = nb >> 3, w32 = (nb & 7) * 32;
                const int p8 = RUNS_F8.inv(t);
                if (p8 >= 0) transpose_item8(a->in[3], a->in[2], F8_SB, DM, NIN, ws + WS_WIN + 8 * MiB, scr, r, lane, p8 * 256 + w32);
                else transpose_item(a->in[3], a->in[2], DM, NIN, (bf16_t*)(ws + WS_WIN), scr, r, lane, RUNS_B16.inv(t) * 256 + w32);
                continue; } r -= I_IN;
            if (r < I_Q) { transpose_item(a->in[5], a->in[4], 256, 768, (bf16_t*)(ws + WS_WQ), scr, r, lane); continue; } r -= I_Q;
            if (r < I_KV) { transpose_item(a->in[7], a->in[6], 128, 1024, (bf16_t*)(ws + WS_WKV), scr, r, lane); continue; } r -= I_KV;
            if (r < I_OA) { transpose_item(a->in[8], nullptr, 512, 1024, (bf16_t*)(ws + WS_WOA), scr, r, lane); continue; } r -= I_OA;
            if (r < I_OA) { transpose_item(a->in[9], nullptr, 512, 1024, (bf16_t*)(ws + WS_WOB), scr, r, lane); continue; } r -= I_OA;
            transpose_item(a->in[10], nullptr, 1024, 1024, (bf16_t*)(ws + WS_WO), scr, r, lane);
        }
        { static_assert(RUNS_F8.inv(31) >= 0, "the padded tile is an fp8 tile");
          u32x4* pad = (u32x4*)(ws + WS_WIN + 8 * MiB + (size_t)(RUNS_F8.inv(31) * 256 + (NIN - 31 * 256)) * DM); const int n16 = (NINP - NIN) * DM / 16;
          unsigned zu = 0u; asm volatile("" : "+v"(zu));
          for (int i = gw * 64 + lane; i < n16; i += NGW * 64) pad[i] = (u32x4){zu, zu, zu, zu}; }
        { float* tabA = (float*)(ws + WS_TABA); float* tabB = (float*)(ws + WS_TABB);
          for (int i = gw * 64 + lane; i < SEQ * 24; i += NGW * 64) {
              const int pos = i / 24, f = i % 24; float cv, sv;
              const double inv = kInvFreq[f];
              sincos_d((double)pos * inv, cv, sv);
              if (f < 8) { tabA[pos * 16 + f] = cv; tabA[pos * 16 + 8 + f] = sv; }
              else { tabB[pos * 32 + (f - 8)] = cv; tabB[pos * 32 + 16 + (f - 8)] = sv; }
          } }
    }
    {
        const int s0 = g * GS;
        const float* xg = (s0 < NPSEQ) ? a->in[0] + (size_t)s0 * SEQ * DM : a->in[1] + (size_t)(s0 - NPSEQ) * SEQ * DM;
        bf16_t* HB = (bf16_t*)(ws + WS_HB); unsigned char* HB8 = ws + WS_HB8;
        float* ssqg = ssq + (size_t)g * TG * 4;
        float zf = 0.f; asm volatile("" : "+v"(zf));
        for (int row = gw; row < TG; row += 2 * NGW) {
            const int row1 = row + NGW; const bool has1 = row1 < TG; const int r1 = has1 ? row1 : row;
            const f32x4* xr0 = (const f32x4*)(xg + (size_t)row * DM) + lane; const f32x4* xr1 = (const f32x4*)(xg + (size_t)r1 * DM) + lane;
            f32x4 v0[4], v1[4]; float s0 = 0.f, s1 = 0.f;
#pragma unroll
            for (int j = 0; j < 4; ++j) { v0[j] = __builtin_nontemporal_load(xr0 + 64 * j); v1[j] = __builtin_nontemporal_load(xr1 + 64 * j); }
#pragma unroll
            for (int j = 0; j < 4; ++j) { s0 += (v0[j][0] * v0[j][0] + v0[j][1] * v0[j][1]) + (v0[j][2] * v0[j][2] + v0[j][3] * v0[j][3]); s1 += (v1[j][0] * v1[j][0] + v1[j][1] * v1[j][1]) + (v1[j][2] * v1[j][2] + v1[j][3] * v1[j][3]); }
            const float rstd0 = rsqrtf(wave_sum(s0) * (1.0f / DM) + EPS), rstd1 = rsqrtf(wave_sum(s1) * (1.0f / DM) + EPS);
            unsigned* o80 = (unsigned*)(HB8 + (size_t)row * DM) + lane; unsigned* o81 = (unsigned*)(HB8 + (size_t)r1 * DM) + lane;
            u32x2* b80 = (u32x2*)(HB + (size_t)row * DM) + lane; u32x2* b81 = (u32x2*)(HB + (size_t)r1 * DM) + lane;
            const float q0 = rstd0 * F8_SA, q1 = rstd1 * F8_SA;
#pragma unroll
            for (int j = 0; j < 4; ++j) { o80[64 * j] = (unsigned)pk4_fp8(v0[j][0] * q0, v0[j][1] * q0, v0[j][2] * q0, v0[j][3] * q0);
                u32x2 w; w.x = pk_bf16(v0[j][0] * rstd0, v0[j][1] * rstd0); w.y = pk_bf16(v0[j][2] * rstd0, v0[j][3] * rstd0); b80[64 * j] = w; }
            if (has1) {
#pragma unroll
                for (int j = 0; j < 4; ++j) { o81[64 * j] = (unsigned)pk4_fp8(v1[j][0] * q1, v1[j][1] * q1, v1[j][2] * q1, v1[j][3] * q1);
                    u32x2 w; w.x = pk_bf16(v1[j][0] * rstd1, v1[j][1] * rstd1); w.y = pk_bf16(v1[j][2] * rstd1, v1[j][3] * rstd1); b81[64 * j] = w; }
            }
            if (lane == 0) { *(f32x4*)(ssqg + (size_t)row * 4) = (f32x4){zf, zf, zf, zf}; if (has1) *(f32x4*)(ssqg + (size_t)row1 * 4) = (f32x4){zf, zf, zf, zf}; }
        }
    }
}

template <class AP> __device__ __forceinline__ void final_norm(AP a, const int g, const int G, const int bid) {
    int tid_ = threadIdx.x; asm volatile("" : "+v"(tid_));
    const int lane = tid_ & 63, wave = __builtin_amdgcn_readfirstlane(tid_ >> 6), gw = bid * 8 + wave, NGW = G * 8;
    const int s0 = g * GS;
    const float* xg = (s0 < NPSEQ) ? a->in[0] + (size_t)s0 * SEQ * DM : a->in[1] + (size_t)(s0 - NPSEQ) * SEQ * DM;
    const bf16_t* DL = (const bf16_t*)(a->ws + WS_UA);
    float* og = a->out + (size_t)g * TG * DM;
    const f32x4* gf = (const f32x4*)a->in[11] + lane;
    for (int row = gw; row < TG; row += 2 * NGW) {
        const int row1 = row + NGW; const bool has1 = row1 < TG; const int r1 = has1 ? row1 : row;
        const f32x4* xr0 = (const f32x4*)(xg + (size_t)row * DM) + lane; const f32x4* xr1 = (const f32x4*)(xg + (size_t)r1 * DM) + lane;
        const u32x2* dr0 = (const u32x2*)(DL + (size_t)row * DM) + lane; const u32x2* dr1 = (const u32x2*)(DL + (size_t)r1 * DM) + lane;
        f32x4 v0[4], v1[4]; u32x2 d0[4], d1[4]; float s0 = 0.f, s1 = 0.f;
#pragma unroll
        for (int j = 0; j < 4; ++j) { v0[j] = __builtin_nontemporal_load(xr0 + 64 * j); d0[j] = dr0[64 * j]; v1[j] = __builtin_nontemporal_load(xr1 + 64 * j); d1[j] = dr1[64 * j]; }
#pragma unroll
        for (int j = 0; j < 4; ++j) {
            v0[j] = v0[j] + (f32x4){bf_lo(d0[j].x), bf_hi(d0[j].x), bf_lo(d0[j].y), bf_hi(d0[j].y)}; v1[j] = v1[j] + (f32x4){bf_lo(d1[j].x), bf_hi(d1[j].x), bf_lo(d1[j].y), bf_hi(d1[j].y)};
            s0 += (v0[j][0] * v0[j][0] + v0[j][1] * v0[j][1]) + (v0[j][2] * v0[j][2] + v0[j][3] * v0[j][3]); s1 += (v1[j][0] * v1[j][0] + v1[j][1] * v1[j][1]) + (v1[j][2] * v1[j][2] + v1[j][3] * v1[j][3]); }
        const float rstd0 = rsqrtf(wave_sum(s0) * (1.0f / DM) + EPS), rstd1 = rsqrtf(wave_sum(s1) * (1.0f / DM) + EPS);
        f32x4* or0 = (f32x4*)(og + (size_t)row * DM) + lane; f32x4* or1 = (f32x4*)(og + (size_t)r1 * DM) + lane;
#pragma unroll
        for (int j = 0; j < 4; ++j) { const f32x4 gj = gf[64 * j]; __builtin_nontemporal_store(v0[j] * rstd0 * gj, or0 + 64 * j); if (has1) __builtin_nontemporal_store(v1[j] * rstd1 * gj, or1 + 64 * j); }
    }
}

__device__ __forceinline__ void combine_phase(unsigned char* ws, const int G, const int bid) {
    int tid_ = threadIdx.x; asm volatile("" : "+v"(tid_));
    const int lane = tid_ & 63, wave = __builtin_amdgcn_readfirstlane(tid_ >> 6), gw = bid * 8 + wave, NGW = G * 8;
    const bf16_t* Z = (const bf16_t*)(ws + WS_Z); const bf16_t* OA = (const bf16_t*)(ws + WS_OA); const float* LSE = (const float*)(ws + WS_LSE); bf16_t* UA = (bf16_t*)(ws + WS_UA);
    const int h = lane >> 3, c = lane & 7;
    for (int t0 = gw; t0 < TG; t0 += 2 * NGW) {
        u32x4 xa[2][3], ga[2]; float la[2][3]; bool has[2];
#pragma unroll
        for (int k = 0; k < 2; ++k) { const int t_ = t0 + k * NGW; has[k] = t_ < TG; const int t = has[k] ? t_ : t0;
            la[k][0] = LSE[(size_t)t * 24 + h]; la[k][1] = LSE[(size_t)t * 24 + 8 + h]; la[k][2] = LSE[(size_t)t * 24 + 16 + h];
            const bf16_t* ar = OA + (size_t)t * 1536 + h * 64 + c * 8;
            xa[k][0] = *(const u32x4*)(ar); xa[k][1] = *(const u32x4*)(ar + 512); xa[k][2] = *(const u32x4*)(ar + 1024);
            ga[k] = *(const u32x4*)(Z + zoff((size_t)t, C_GA + h * 64 + c * 8)); }
#pragma unroll
        for (int k = 0; k < 2; ++k) { if (!has[k]) continue; const int t = t0 + k * NGW;
            const float mx = fmaxf(la[k][0], fmaxf(la[k][1], la[k][2]));
            float e0 = __builtin_amdgcn_exp2f(la[k][0] - mx), e1 = __builtin_amdgcn_exp2f(la[k][1] - mx), e2 = __builtin_amdgcn_exp2f(la[k][2] - mx);
            const float inv = 1.0f / (e0 + e1 + e2); e0 *= inv; e1 *= inv; e2 *= inv;
            u32x4 ov;
#pragma unroll
            for (int w = 0; w < 4; ++w) {
                const float lo = (e0 * bf_lo(xa[k][0][w]) + e1 * bf_lo(xa[k][1][w]) + e2 * bf_lo(xa[k][2][w])) * bf_lo(ga[k][w]);
                const float hh = (e0 * bf_hi(xa[k][0][w]) + e1 * bf_hi(xa[k][1][w]) + e2 * bf_hi(xa[k][2][w])) * bf_hi(ga[k][w]);
                ov[w] = pk_bf16(lo, hh);
            }
            *(u32x4*)(UA + (size_t)t * 512 + h * 64 + c * 8) = ov; }
    }
}

#define XB_TMO      128
#define XB_XCNT(j)  (256  + 64 * (j))
#define XB_XSUB(j)  (1280 + 64 * (j))
#define XB_XGEN(j)  (2304 + 64 * (j))
#define XB_TOP      3328
#define XB_TOPGEN   3392
#define XCD_BAR_WORDS 3456
#define XB_SPIN_CAP (1u << 20)
__device__ __forceinline__ unsigned xb_ld(unsigned* p)              { return __hip_atomic_load(p, __ATOMIC_RELAXED, __HIP_MEMORY_SCOPE_AGENT); }
__device__ __forceinline__ unsigned xb_add(unsigned* p, unsigned v) { return __hip_atomic_fetch_add(p, v, __ATOMIC_RELAXED, __HIP_MEMORY_SCOPE_AGENT); }
__device__ __forceinline__ unsigned xb_xcc_id() { return (unsigned)__builtin_amdgcn_s_getreg((3 << 11) | 20) & 0xFu; }
#define XB_SPIN(cond, bar) do { unsigned _sp = 0; while (cond) { __builtin_amdgcn_s_sleep(1); \
    if ((++_sp & 255u) == 0u) { if (xb_ld(&(bar)[XB_TMO])) break; if (_sp > XB_SPIN_CAP) { atomicAdd(&(bar)[XB_TMO], 1u); break; } } } } while (0)
__device__ __forceinline__ void xcd_barrier_post(unsigned* bar) { if (threadIdx.x == 0) (void)xb_add(&bar[XB_XCNT(xb_xcc_id())], 1u); }
__device__ __forceinline__ void xcd_barrier_complete(unsigned* bar, unsigned x, unsigned& nloc, unsigned& nx) {
    const unsigned G = gridDim.x * gridDim.y * gridDim.z;
    unsigned sum, cnt, mine, sp = 0u;
    for (;;) {
        sum = 0u; cnt = 0u; mine = 0u;
#pragma unroll
        for (unsigned j = 0; j < 16; ++j) { const unsigned c = xb_ld(&bar[XB_XCNT(j)]); sum += c; cnt += (c > 0u) ? 1u : 0u; mine = (j == x) ? c : mine; }
        if (sum == G) break;
        __builtin_amdgcn_s_sleep(1);
        if ((++sp & 255u) == 0u) { if (xb_ld(&bar[XB_TMO])) break; if (sp > XB_SPIN_CAP) { atomicAdd(&bar[XB_TMO], 1u); break; } }
    }
    nloc = mine > 0u ? mine : 1u; nx = cnt > 0u ? cnt : 1u;
}
__device__ __forceinline__ void xcd_barrier(unsigned* bar, volatile LAS unsigned* st) {
    asm volatile("s_waitcnt vmcnt(0)" ::: "memory");
    __syncthreads();
    if (threadIdx.x == 0) {
        const unsigned x = xb_xcc_id();
        __builtin_amdgcn_s_waitcnt(0);
        unsigned nloc = st[0], nx = st[1];
        if (nloc == 0u) { xcd_barrier_complete(bar, x, nloc, nx); st[0] = nloc; st[1] = nx; }
        const unsigned old = xb_add(&bar[XB_XSUB(x)], 1u);
        const unsigned gen = old / nloc;
        if (old + 1u == (gen + 1u) * nloc) {
            __builtin_amdgcn_fence(__ATOMIC_RELEASE, "agent");
            asm volatile("s_waitcnt vmcnt(0)" ::: "memory");
            const unsigned og = xb_add(&bar[XB_TOP], 1u);
            const unsigned tg = og / nx;
            if (og + 1u == (tg + 1u) * nx) xb_add(&bar[XB_TOPGEN], 1u);
            else XB_SPIN(xb_ld(&bar[XB_TOPGEN]) == tg, bar);
            __builtin_amdgcn_fence(__ATOMIC_ACQUIRE, "agent");
            xb_add(&bar[XB_XGEN(x)], 1u);
            asm volatile("s_waitcnt vmcnt(0)" ::: "memory");
        } else {
            XB_SPIN(xb_ld(&bar[XB_XGEN(x)]) == gen, bar);
            __builtin_amdgcn_fence(__ATOMIC_ACQUIRE, "agent");
            asm volatile("s_waitcnt vmcnt(0)" ::: "memory");
        }
    }
    __syncthreads();
}

__global__ void __launch_bounds__(512, 2) mega_fwd(Args a) {
    extern __shared__ __attribute__((aligned(16))) unsigned char lds_raw[];
    LAS unsigned char* lds = (LAS unsigned char*)lds_raw;
    cg::grid_group grid = cg::this_grid();
    volatile LAS unsigned* bst = (volatile LAS unsigned*)(lds + 131072);
    if (threadIdx.x == 0) { bst[0] = 0u; bst[1] = 0u; }
    __syncthreads();
    xcd_barrier_post((unsigned*)(a.ws + WS_BAR));
    for (int ph = a.ph_lo; ph < a.ph_hi; ++ph) {
        if (ph == a.ph_lo + 1) grid.sync();
        else if (ph > a.ph_lo) { unsigned* bar = (unsigned*)(a.ws + WS_BAR); asm volatile("" : "+s"(bar)); xcd_barrier(bar, bst); }
        typedef const __attribute__((address_space(4))) Args* kargp_t;
        kargp_t ap = (kargp_t)__builtin_amdgcn_kernarg_segment_ptr();
        asm volatile("" : "+s"(ap));
        unsigned char* ws = ap->ws;
        int G = gridDim.x, bid = blockIdx.x;
        asm volatile("" : "+s"(G), "+s"(bid));
        const int vcu = (G % 8 == 0) ? (bid % 8) * (G / 8) + bid / 8 : bid;
        bf16_t* Z = (bf16_t*)(ws + WS_Z); bf16_t* HB = (bf16_t*)(ws + WS_HB); bf16_t* QB = (bf16_t*)(ws + WS_QB); bf16_t* KVB = (bf16_t*)(ws + WS_KVB);
        bf16_t* UA = (bf16_t*)(ws + WS_UA); bf16_t* UB = (bf16_t*)(ws + WS_UB); bf16_t* MG = (bf16_t*)(ws + WS_MG);
        float* LSE = (float*)(ws + WS_LSE); float* SSQ = (float*)(ws + WS_SSQ); bf16_t* OA = (bf16_t*)(ws + WS_OA);
        const float* tabA = (const float*)(ws + WS_TABA); const float* tabB = (const float*)(ws + WS_TABB);
        if (ph == NG * NPH) { final_norm(ap, NG - 1, G, bid); break; }
        const int g = ph / NPH, k = ph % NPH;
        float* ssqg = SSQ + (size_t)g * TG * 4;
        if (k == 0 && (PHM & 1)) {
            prep_phase(ap, lds, g, G, bid);
            if (g > 0) final_norm(ap, g - 1, G, bid);
            __syncthreads();
        } else if (k == 1 && (PHM & 2)) {
            { pg8::Gemm gm{HB, (const bf16_t*)(ws + WS_WIN), TG, RUNS_B16.count() * 256, DM, DM, 128}; pg8::StaticOrder S; S.init(TG, RUNS_B16.count() * 256, G, bid);
              EpiZ E{Z, ssqg, tabA, tabB, RUNS_B16, 1.0f};
              pg8::gemm_phase<EpiZ, pg8::StaticOrder, true, true, false>(lds, gm, S, E); }
            { pg8::Gemm gm{(const bf16_t*)(ws + WS_HB8), (const bf16_t*)(ws + WS_WIN + 8 * MiB), TG, RUNS_F8.count() * 256, DM / 2, DM / 2, 128}; pg8::StaticOrder S; S.init(TG, RUNS_F8.count() * 256, G, bid);
              EpiZ E{Z, ssqg, tabA, tabB, RUNS_F8, F8_DQ};
              pg8::gemm_phase<EpiZ, pg8::StaticOrder, true, true, true>(lds, gm, S, E); }
        } else if (k == 2 && (PHM & 4)) {
            { pg8::Gemm gm{Z + zoff(0, C_QL), (const bf16_t*)(ws + WS_WQ), TG, 768, 256, 64, ZBLK * 2};   pg8::StaticOrder S; S.init(TG, 768, G, bid);
              EpiQ E{QB, ssqg, tabB};
              pg8::gemm_phase<EpiQ, pg8::StaticOrder, true, true>(lds, gm, S, E); }
            { pg8::Gemm gm{Z + zoff(0, C_KVL), (const bf16_t*)(ws + WS_WKV), TG, 1024, 128, 64, ZBLK * 2}; pg8::StaticOrder S; S.init(TG, 1024, G, bid);
              EpiKV E{KVB, ssqg};
              pg8::gemm_phase<EpiKV, pg8::StaticOrder, true, true>(lds, gm, S, E); }
            __syncthreads();
            for (int u = vcu; u < GS * 24 * 16; u += G) { const int u16 = u & 15, gh = (u >> 4) % 24, sb = (u >> 4) / 24; dil_unit(lds, Z, OA, LSE, sb, gh, u16); }
        } else if (k == 3 && (PHM & 8)) {
            combine_phase(ws, G, bid);
            for (int u = vcu; u < GS * 8 * 16; u += G) { const int qb = u & 15, h = (u >> 4) & 7, sb = u >> 7; mla_unit(lds, QB, KVB, Z, UB, sb, h, qb); }
        } else if (k == 4 && (PHM & 16)) {
            pg8::StaticOrder S; S.init(TG, DM, G, bid);
            { pg8::Gemm gm{UA, (const bf16_t*)(ws + WS_WOA), TG, DM, 512, 512, 128}; EpiMerge<false> E{MG, Z, C_MGA};
              pg8::gemm_phase<EpiMerge<false>, pg8::StaticOrder, true, true>(lds, gm, S, E); }
            { pg8::Gemm gm{UB, (const bf16_t*)(ws + WS_WOB), TG, DM, 512, 512, 128}; EpiMerge<true> E{MG, Z, C_MGB};
              pg8::gemm_phase<EpiMerge<true>, pg8::StaticOrder, true, true>(lds, gm, S, E); }
        } else if (k == 5 && (PHM & 32)) {
            pg8::Gemm gm{MG, (const bf16_t*)(ws + WS_WO), TG, DM, DM, DM, 128}; pg8::StaticOrder S; S.init(TG, DM, G, bid);
            EpiDelta E{UA};
            pg8::gemm_phase<EpiDelta, pg8::StaticOrder, true, true>(lds, gm, S, E);
        }
    }
}

#ifndef PHM
#define PHM 63
#endif
#ifndef MK_COOP
#define MK_COOP 1
#endif
extern "C" void kernel_launch(void* const* d_in, const int* in_sizes, int n_in, void* d_out, int out_size, void* d_ws, size_t ws_size, hipStream_t stream) {
    static int grid = 0;
    if (grid == 0) {
        if (n_in != 12 || ws_size < WS_END || out_size != NSEQ * SEQ * DM) { fprintf(stderr, "kernel_launch: unexpected sizes (n_in %d, ws %zu, out %d)\n", n_in, ws_size, out_size); grid = -1; return; }
        int dev = 0, cus = 0, per_cu = 0;
        (void)hipGetDevice(&dev);
        (void)hipDeviceGetAttribute(&cus, hipDeviceAttributeMultiprocessorCount, dev);
        if (hipFuncSetAttribute((const void*)mega_fwd, hipFuncAttributeMaxDynamicSharedMemorySize, LDS_BYTES) != hipSuccess) { fprintf(stderr, "kernel_launch: hipFuncSetAttribute failed\n"); grid = -1; return; }
        if (hipOccupancyMaxActiveBlocksPerMultiprocessor(&per_cu, (const void*)mega_fwd, 512, LDS_BYTES) != hipSuccess || per_cu < 1) { fprintf(stderr, "kernel_launch: occupancy query failed (%d)\n", per_cu); per_cu = 1; }
        (void)hipGetLastError();
        grid = cus * per_cu;
        if (grid <= 0) grid = 256;
    }
    if (grid < 0) return;
    (void)hipMemsetAsync((unsigned char*)d_ws + WS_BAR, 0, XCD_BAR_WORDS * 4, stream);
    Args a{};
    for (int i = 0; i < 12; ++i) a.in[i] = (const float*)d_in[i];
    a.out = (float*)d_out; a.ws = (unsigned char*)d_ws;
#if MK_COOP
    a.ph_lo = 0; a.ph_hi = PH_TOTAL;
    void* args[] = {&a};
    hipError_t e = hipLaunchCooperativeKernel((const void*)mega_fwd, dim3(grid), dim3(512), args, LDS_BYTES, stream);
    if (e != hipSuccess) fprintf(stderr, "kernel_launch: cooperative launch failed: %s (grid %d)\n", hipGetErrorString(e), grid);
#else
    for (int ph = 0; ph < PH_TOTAL; ++ph) { a.ph_lo = ph; a.ph_hi = ph + 1; hipLaunchKernelGGL(mega_fwd, dim3(grid), dim3(512), LDS_BYTES, stream, a); }
#endif
}
```
